# Optimizing an MI355X kernel written in HIP

```python
import math
import jax, jax.numpy as jnp
from jax import lax
import numpy as np

D_MODEL = 1024
BATCH = 2
SEQ = 16384
DEPTH = 4
DEC_BATCH = 32
DEC_SEQ = 2048
PAST_LEN = 128

N_MIXERS = 2
N_ATTN_LAYERS = (DEPTH + 1) // 2
N_MLSTM_LAYERS = DEPTH // 2

ATTN_HEADS = 16
ATTN_KV_HEADS = 4
ATTN_GROUP = ATTN_HEADS // ATTN_KV_HEADS
ATTN_HEAD_DIM = D_MODEL // ATTN_HEADS
ATTN_WIDTH = ATTN_HEADS * ATTN_HEAD_DIM
ATTN_KV_WIDTH = ATTN_KV_HEADS * ATTN_HEAD_DIM
ATTN_IN = 2 * ATTN_WIDTH + 2 * ATTN_KV_WIDTH
WINDOW = 128
BLOCK = 128
ROPE_THETA = 10000.0

MLSTM_HEADS = 4
MLSTM_V_DIM = D_MODEL // MLSTM_HEADS
MLSTM_QK_DIM = MLSTM_V_DIM // 2
MLSTM_WIDTH = MLSTM_HEADS * MLSTM_V_DIM
MLSTM_QK_WIDTH = MLSTM_HEADS * MLSTM_QK_DIM
MLSTM_N_GATES = 4 * MLSTM_HEADS
MLSTM_IN = 2 * MLSTM_QK_WIDTH + 3 * MLSTM_WIDTH + MLSTM_N_GATES
CHUNK = 64

EPS = 1e-6
NEG_INIT = -1e30

kernel_name = 'hybrid_swa_mlstm_bidir_encoder'


def rms_norm(x, g):
    xf = x.astype(jnp.float32)
    y = xf * lax.rsqrt(jnp.mean(xf * xf, axis=-1, keepdims=True) + EPS)
    return (y * g.astype(jnp.float32)).astype(x.dtype)


def rope(x, pos):
    half = x.shape[-1] // 2
    inv = jnp.exp(-math.log(ROPE_THETA) * jnp.arange(half, dtype=jnp.float32) / half)
    ang = pos.astype(jnp.float32)[:, None] * inv[None, :]
    cos = jnp.cos(ang)[None, :, None, :]
    sin = jnp.sin(ang)[None, :, None, :]
    xf = x.astype(jnp.float32)
    x1, x2 = xf[..., :half], xf[..., half:]
    return jnp.concatenate([x1 * cos - x2 * sin, x2 * cos + x1 * sin], axis=-1).astype(x.dtype)


def window_attention_mixer(xn, w_in, sink, w_out):
    B, S, _ = xn.shape
    NB = S // BLOCK
    proj = xn @ w_in
    q, k, v, z = jnp.split(proj, [ATTN_WIDTH, ATTN_WIDTH + ATTN_KV_WIDTH, ATTN_WIDTH + 2 * ATTN_KV_WIDTH], axis=-1)
    pos = jnp.arange(S)
    q = rope(q.reshape(B, S, ATTN_HEADS, ATTN_HEAD_DIM), pos)
    k = rope(k.reshape(B, S, ATTN_KV_HEADS, ATTN_HEAD_DIM), pos)
    v = v.reshape(B, S, ATTN_KV_HEADS, ATTN_HEAD_DIM)
    qb = q.reshape(B, NB, BLOCK, ATTN_KV_HEADS, ATTN_GROUP, ATTN_HEAD_DIM)

    def band(t):
        tp = jnp.pad(t, ((0, 0), (BLOCK, BLOCK), (0, 0), (0, 0)))
        tp = tp.reshape(B, NB + 2, BLOCK, ATTN_KV_HEADS, ATTN_HEAD_DIM)
        return jnp.concatenate([tp[:, :-2], tp[:, 1:-1], tp[:, 2:]], axis=2)

    kb, vb = band(k), band(v)
    s = jnp.einsum('bnqgrd,bnkgd->bngrqk', qb, kb, preferred_element_type=jnp.float32)
    s = s * (ATTN_HEAD_DIM ** -0.5)
    a = jnp.arange(BLOCK)
    c = jnp.arange(3 * BLOCK)
    in_band = jnp.abs(c[None, :] - BLOCK - a[:, None]) <= WINDOW
    key_pos = jnp.arange(NB)[:, None] * BLOCK - BLOCK + c[None, :]
    in_seq = (key_pos >= 0) & (key_pos < S)
    mask = in_band[None, :, :] & in_seq[:, None, :]
    s = jnp.where(mask[None, :, None, None], s, -jnp.inf)
    sk = sink.astype(jnp.float32).reshape(ATTN_KV_HEADS, ATTN_GROUP)[None, None, :, :, None, None]
    m = jnp.maximum(jnp.max(s, axis=-1, keepdims=True), sk)
    p = jnp.exp(s - m)
    den = jnp.sum(p, axis=-1, keepdims=True) + jnp.exp(sk - m)
    p = (p / den).astype(vb.dtype)
    o = jnp.einsum('bngrqk,bnkgd->bnqgrd', p, vb).reshape(B, S, ATTN_WIDTH)
    return (o * jax.nn.silu(z)) @ w_out


def mlstm_chunkwise(q, k, v, ig, fg):
    B, S, H, DQK = q.shape
    DV = v.shape[-1]
    NC = S // CHUNK

    def chunks(t):
        return t.astype(jnp.float32).reshape(B, NC, CHUNK, H, -1).transpose(0, 3, 1, 2, 4)

    qc, kc, vc = chunks(q), chunks(k), chunks(v)
    igc = ig.reshape(B, NC, CHUNK, H).transpose(0, 3, 1, 2)
    logf = jax.nn.log_sigmoid(fg.reshape(B, NC, CHUNK, H).transpose(0, 3, 1, 2))
    b = jnp.cumsum(logf, axis=-1)
    b_end = b[..., -1]
    tri = jnp.tril(jnp.ones((CHUNK, CHUNK), dtype=bool))
    D = jnp.where(tri, b[..., :, None] - b[..., None, :] + igc[..., None, :], -jnp.inf)

    a = b_end[..., None] - b + igc
    m_loc = jnp.max(a, axis=-1)
    w = jnp.exp(a - m_loc[..., None])
    C_loc = jnp.einsum('bhcsk,bhcsv->bhckv', w[..., None] * kc, vc)
    n_loc = jnp.einsum('bhcs,bhcsk->bhck', w, kc)

    def step(carry, inp):
        C, n, m = carry
        C_l, n_l, m_l, be = inp
        m_new = jnp.maximum(be + m, m_l)
        sp = jnp.exp(be + m - m_new)
        sl = jnp.exp(m_l - m_new)
        C_new = sp[..., None, None] * C + sl[..., None, None] * C_l
        n_new = sp[..., None] * n + sl[..., None] * n_l
        return (C_new, n_new, m_new), (C, n, m)

    xs = (jnp.moveaxis(C_loc, 2, 0), jnp.moveaxis(n_loc, 2, 0), jnp.moveaxis(m_loc, 2, 0), jnp.moveaxis(b_end, 2, 0))
    init = (jnp.zeros((B, H, DQK, DV), jnp.float32), jnp.zeros((B, H, DQK), jnp.float32),
            jnp.full((B, H), NEG_INIT, jnp.float32))
    _, (Cs, ns, ms) = lax.scan(step, init, xs)
    Cs = jnp.moveaxis(Cs, 0, 2)
    ns = jnp.moveaxis(ns, 0, 2)
    ms = jnp.moveaxis(ms, 0, 2)

    g_prev = b + ms[..., None]
    m_t = jnp.maximum(jnp.max(D, axis=-1), g_prev)
    P = jnp.exp(D - m_t[..., None]) * jnp.einsum('bhctk,bhcsk->bhcts', qc, kc)
    sc = jnp.exp(g_prev - m_t)
    num = jnp.einsum('bhcts,bhcsv->bhctv', P, vc) + sc[..., None] * jnp.einsum('bhctk,bhckv->bhctv', qc, Cs)
    den = jnp.sum(P, axis=-1) + sc * jnp.einsum('bhctk,bhck->bhct', qc, ns)
    h = num / jnp.maximum(jnp.abs(den), jnp.exp(-m_t))[..., None]
    return h.transpose(0, 2, 3, 1, 4).reshape(B, S, H, DV)


def mlstm_mixer(xn, w_in, gate_bias, head_norm, w_out):
    B, S, _ = xn.shape
    cuts = [MLSTM_QK_WIDTH, 2 * MLSTM_QK_WIDTH, 2 * MLSTM_QK_WIDTH + MLSTM_WIDTH,
            2 * MLSTM_QK_WIDTH + 2 * MLSTM_WIDTH, 2 * MLSTM_QK_WIDTH + 3 * MLSTM_WIDTH]
    proj = xn @ w_in
    q, k, v, o, z, g = jnp.split(proj, cuts, axis=-1)
    q = q.reshape(B, S, MLSTM_HEADS, MLSTM_QK_DIM)
    k = k.reshape(B, S, MLSTM_HEADS, MLSTM_QK_DIM) * (MLSTM_QK_DIM ** -0.5)
    v = v.reshape(B, S, MLSTM_HEADS, MLSTM_V_DIM)
    g = (g.astype(jnp.float32) + gate_bias.astype(jnp.float32)).reshape(B, S, 4, MLSTM_HEADS)
    ig_f, fg_f, ig_b, fg_b = g[:, :, 0], g[:, :, 1], g[:, :, 2], g[:, :, 3]
    h_f = mlstm_chunkwise(q, k, v, ig_f, fg_f)
    flip = lambda t: jnp.flip(t, axis=1)
    h_b = flip(mlstm_chunkwise(flip(q), flip(k), flip(v), flip(ig_b), flip(fg_b)))
    h = h_f + h_b
    h = h * lax.rsqrt(jnp.mean(h * h, axis=-1, keepdims=True) + EPS)
    h = h * head_norm.astype(jnp.float32).reshape(MLSTM_HEADS, MLSTM_V_DIM)
    h = h.reshape(B, S, MLSTM_WIDTH).astype(xn.dtype)
    h = h * jax.nn.sigmoid(o) * jax.nn.silu(z)
    return h @ w_out


def trunk(x, norm_g, attn_w_in, attn_sink, attn_w_out, mlstm_w_in, mlstm_gate_bias, mlstm_head_norm, mlstm_w_out, final_norm_g):
    for i in range(DEPTH):
        j = i // N_MIXERS
        xn = rms_norm(x, norm_g[i])
        if i % N_MIXERS == 0:
            x = x + window_attention_mixer(xn, attn_w_in[j], attn_sink[j], attn_w_out[j])
        else:
            x = x + mlstm_mixer(xn, mlstm_w_in[j], mlstm_gate_bias[j], mlstm_head_norm[j], mlstm_w_out[j])
    return rms_norm(x, final_norm_g)


def setup_inputs(seed: int = 0) -> dict:
    key = jax.random.key(seed)
    ks = jax.random.split(key, 14)
    f32 = jnp.float32
    x_prompt = jax.random.normal(ks[0], (BATCH, SEQ, D_MODEL), f32)
    x_sample = jax.random.normal(ks[1], (DEC_BATCH, DEC_SEQ, D_MODEL), f32)
    norm_g = 1.0 + 0.02 * jax.random.normal(ks[2], (DEPTH, D_MODEL), f32)
    attn_w_in = jax.random.normal(ks[3], (N_ATTN_LAYERS, D_MODEL, ATTN_IN), f32) * D_MODEL ** -0.5
    attn_sink = 0.5 * jax.random.normal(ks[4], (N_ATTN_LAYERS, ATTN_HEADS), f32)
    attn_w_out = jax.random.normal(ks[5], (N_ATTN_LAYERS, ATTN_WIDTH, D_MODEL), f32) * ATTN_WIDTH ** -0.5
    mlstm_w_in = jax.random.normal(ks[6], (N_MLSTM_LAYERS, D_MODEL, MLSTM_IN), f32) * D_MODEL ** -0.5
    ig_bias = 0.1 * jax.random.normal(ks[7], (N_MLSTM_LAYERS, 2, MLSTM_HEADS), f32)
    fg_bias = jnp.linspace(3.0, 6.0, MLSTM_HEADS, dtype=f32)[None, None, :] + 0.1 * jax.random.normal(ks[8], (N_MLSTM_LAYERS, 2, MLSTM_HEADS), f32)
    mlstm_gate_bias = jnp.stack([ig_bias[:, 0], fg_bias[:, 0], ig_bias[:, 1], fg_bias[:, 1]], axis=1).reshape(N_MLSTM_LAYERS, MLSTM_N_GATES)
    mlstm_head_norm = 1.0 + 0.02 * jax.random.normal(ks[9], (N_MLSTM_LAYERS, MLSTM_WIDTH), f32)
    mlstm_w_out = jax.random.normal(ks[10], (N_MLSTM_LAYERS, MLSTM_WIDTH, D_MODEL), f32) * MLSTM_WIDTH ** -0.5
    final_norm_g = 1.0 + 0.02 * jax.random.normal(ks[11], (D_MODEL,), f32)
    return {'x_prompt': x_prompt, 'x_sample': x_sample, 'norm_g': norm_g,
            'attn_w_in': attn_w_in, 'attn_sink': attn_sink, 'attn_w_out': attn_w_out,
            'mlstm_w_in': mlstm_w_in, 'mlstm_gate_bias': mlstm_gate_bias,
            'mlstm_head_norm': mlstm_head_norm, 'mlstm_w_out': mlstm_w_out,
            'final_norm_g': final_norm_g}


def reference(x_prompt, x_sample, norm_g, attn_w_in, attn_sink, attn_w_out, mlstm_w_in, mlstm_gate_bias, mlstm_head_norm, mlstm_w_out, final_norm_g):
    y_prompt = trunk(x_prompt, norm_g, attn_w_in, attn_sink, attn_w_out, mlstm_w_in, mlstm_gate_bias, mlstm_head_norm, mlstm_w_out, final_norm_g)
    y_sample = trunk(x_sample, norm_g, attn_w_in, attn_sink, attn_w_out, mlstm_w_in, mlstm_gate_bias, mlstm_head_norm, mlstm_w_out, final_norm_g)
    return (y_prompt, y_sample)
```

```cpp
#include <hip/hip_runtime.h>
#include <hip/hip_cooperative_groups.h>
#include <cstdio>
#include <cstdint>
namespace cg = cooperative_groups;
#define MK_MULTI 0
__device__ __forceinline__ int opaque_tid() { int t = threadIdx.x; asm volatile("" : "+v"(t)); return t; }
__device__ __forceinline__ int opaque_bid() { int t = blockIdx.x; asm volatile("" : "+s"(t)); return t; }
namespace pg8 {
#define PG8_LAS __attribute__((address_space(3)))
typedef unsigned short bf16_t;
typedef short bf16x8 __attribute__((ext_vector_type(8)));
typedef float f32x4 __attribute__((ext_vector_type(4)));
typedef unsigned u32x4 __attribute__((ext_vector_type(4)));
constexpr int BM = 256, BK = 64, HALF = 128, HTB = HALF * BK * 2  , STAGE_BYTES = 8 * HTB, NXCD = 8, WGM = 8;

__host__ __device__ __forceinline__ int lds_byte(int r, int c) { const int st = (r >> 4) * 2 + (c >> 5), rr = r & 15, cc = c & 31, ob = rr * 64 + cc * 2; return st * 1024 + (ob ^ (((ob >> 9) & 1) << 5)); }
__host__ __device__ __forceinline__ void stage_rc(int b, int& R, int& C) { const int st = b / 1024, sb = b % 1024, swz = sb ^ (((sb >> 9) & 1) << 5); R = (st >> 1) * 16 + swz / 64; C = (st & 1) * 32 + (swz % 64) / 2; }
__host__ __device__ __forceinline__ int perm32(int rho) { const int n = rho >> 4, i = rho & 15; return 8 * (i >> 2) + 4 * n + (i & 3); }

struct Unit { int pm, pn; };
struct Gemm { const bf16_t* A; const bf16_t* Bt; int M, N, K; };

struct StaticOrder {
    int nM, nN, nwg, G, c;
    __host__ __device__ void init(int M, int N, int G_, int c_) { nM = M / BM; nN = N / BM; nwg = nM * nN; G = G_; c = c_; }
    __host__ __device__ bool next(int i, Unit& u) const {
        const long L = (long)i * G + c; if (L >= nwg) return false;
        int wgid = (int)L; { const int q = nwg / NXCD, r = nwg % NXCD, xcd = wgid % NXCD, off = wgid / NXCD; wgid = (xcd < r ? xcd * (q + 1) : r * (q + 1) + (xcd - r) * q) + off; }
        const int nig = WGM * nN, gid = wgid / nig, fm = gid * WGM, gsz = (nM - fm) < WGM ? (nM - fm) : WGM;
        u.pm = fm + ((wgid % nig) % gsz); u.pn = (wgid % nig) / gsz; return true;
    }
    __device__ __forceinline__ void a_ready(const Unit&) const {}
    __device__ __forceinline__ void done(const Unit&) const {}
};

__device__ __forceinline__ unsigned cvt_pk_bf16(float lo, float hi) { unsigned r; asm volatile("v_cvt_pk_bf16_f32 %0, %1, %2" : "=v"(r) : "v"(lo), "v"(hi)); return r; }
typedef float f32x2 __attribute__((ext_vector_type(2)));

template <class Epi, class Sched, bool ALIGN_EPI = false, bool SP2 = false>
__device__ __forceinline__ void gemm_phase(PG8_LAS unsigned char* lds, const Gemm g, const Sched& S, const Epi& E) {
    const int tid = opaque_tid(), wid = __builtin_amdgcn_readfirstlane(tid >> 6), lane = tid & 63, wr = wid >> 2, wc = wid & 3, fr = lane & 15, fq = lane >> 4;
    const int K = g.K, nt = K / BK;
    unsigned voffA[2], voffB[2];
#pragma unroll
    for (int i = 0; i < 2; ++i) { int R, C; stage_rc(tid * 16 + i * 8192, R, C); const int Rb = Epi::PERM ? ((R & ~31) + perm32(R & 31)) : R;
        voffA[i] = (unsigned)(R * K + C) * 2u; voffB[i] = (unsigned)(Rb * K + C) * 2u; }
    const size_t kstep = (size_t)(BK * 2);
    const size_t hstep = (size_t)HALF * K * 2;
    const size_t tstep = 2 * hstep;
    const unsigned ldsw = (unsigned)wid * 1024u;
    const int aoff = lds_byte(wr * 64 + fr, fq * 8), boff = lds_byte(wc * 32 + fr, fq * 8);
#define PG8_SA(b, h) (((b) * 2 + (h)) * HTB)
#define PG8_SB(b, h) ((4 + (b) * 2 + (h)) * HTB)
#define PG8_STAGE(bufoff, gbase, voff) do { _Pragma("unroll") for (int _i = 0; _i < 2; ++_i) \
        __builtin_amdgcn_global_load_lds((const unsigned*)((const char*)(gbase) + (voff)[_i]), (PG8_LAS unsigned*)(lds + (bufoff) + ldsw + _i * 8192), 16, 0, 0); } while (0)
#define PG8_LDA(dst, b, h) do { _Pragma("unroll") for (int m = 0; m < 4; ++m) _Pragma("unroll") for (int k = 0; k < 2; ++k) dst[m][k] = *(const PG8_LAS bf16x8*)(lds + PG8_SA(b, h) + aoff + m * 2048 + k * 1024); } while (0)
#define PG8_LDB(dst, b, h) do { _Pragma("unroll") for (int n = 0; n < 2; ++n) _Pragma("unroll") for (int k = 0; k < 2; ++k) dst[n][k] = *(const PG8_LAS bf16x8*)(lds + PG8_SB(b, h) + boff + n * 2048 + k * 1024); } while (0)
#define PG8_MMA(ai, bj, At, Bt) do { __builtin_amdgcn_s_setprio(1); _Pragma("unroll") for (int m = 0; m < 4; ++m) _Pragma("unroll") for (int n = 0; n < 2; ++n) _Pragma("unroll") for (int k = 0; k < 2; ++k) \
        acc[ai][bj][m][n] = __builtin_amdgcn_mfma_f32_16x16x32_bf16(Bt[n][k], At[m][k], acc[ai][bj][m][n], 0, 0, 0); __builtin_amdgcn_s_setprio(0); } while (0)
#define PG8_WAIT_V(n) asm volatile("s_waitcnt vmcnt(" #n ")" ::: "memory")
#define PG8_WAIT_L(n) asm volatile("s_waitcnt lgkmcnt(" #n ")" ::: "memory")
#define PG8_BAR __builtin_amdgcn_s_barrier()
#define PG8_SCHED __builtin_amdgcn_sched_barrier(0)
    Unit cur, nxt; int ui = 0;
    if (!S.next(0, cur)) return;
    f32x4 acc[2][2][4][2];
#pragma unroll
    for (int a = 0; a < 2; ++a)
#pragma unroll
        for (int b = 0; b < 2; ++b)
#pragma unroll
            for (int m = 0; m < 4; ++m)
#pragma unroll
                for (int n = 0; n < 2; ++n) acc[a][b][m][n] = (f32x4){0.f, 0.f, 0.f, 0.f};
    bf16x8 At[4][2], B0[2][2], B1[2][2];
    const char* cA = (const char*)g.A + (size_t)cur.pm * tstep; const char* cB = (const char*)g.Bt + (size_t)cur.pn * tstep;
    S.a_ready(cur);
    if constexpr (SP2) {
        PG8_STAGE(PG8_SB(0, 0), cB, voffB); PG8_STAGE(PG8_SB(0, 1), cB + hstep, voffB); PG8_STAGE(PG8_SA(0, 0), cA, voffA); PG8_STAGE(PG8_SA(0, 1), cA + hstep, voffA);
        if (wr == 1) PG8_BAR;
        PG8_WAIT_V(2); PG8_BAR;
        PG8_STAGE(PG8_SB(1, 0), cB + kstep, voffB); PG8_STAGE(PG8_SA(1, 0), cA + kstep, voffA); PG8_STAGE(PG8_SB(1, 1), cB + hstep + kstep, voffB);
        PG8_WAIT_V(6); PG8_BAR;
    } else {
        PG8_STAGE(PG8_SB(0, 0), cB, voffB); PG8_STAGE(PG8_SA(0, 0), cA, voffA); PG8_STAGE(PG8_SB(0, 1), cB + hstep, voffB); PG8_STAGE(PG8_SA(0, 1), cA + hstep, voffA);
        if (wr == 1) PG8_BAR;
        PG8_WAIT_V(4); PG8_BAR;
        PG8_STAGE(PG8_SB(1, 0), cB + kstep, voffB); PG8_STAGE(PG8_SA(1, 0), cA + kstep, voffA); PG8_STAGE(PG8_SB(1, 1), cB + hstep + kstep, voffB);
        PG8_WAIT_V(6); PG8_BAR;
    }
    for (;;) {
        const bool has_next = S.next(ui + 1, nxt);
        const char* nA = has_next ? (const char*)g.A + (size_t)nxt.pm * tstep : cA; const char* nB = has_next ? (const char*)g.Bt + (size_t)nxt.pn * tstep : cB;
        for (int t = 0; t < nt; t += 2) {
            const bool last = (t == nt - 2);
            const char* a1 = cA + (size_t)(t + 1) * kstep;
            const char* a2 = last ? nA : cA + (size_t)(t + 2) * kstep; const char* b2 = last ? nB : cB + (size_t)(t + 2) * kstep;
            const char* a3 = a2 + kstep; const char* b3 = b2 + kstep;
            if (last && has_next) S.a_ready(nxt);
            if constexpr (SP2) {
            PG8_LDB(B0, 0, 0); PG8_LDB(B1, 0, 1); PG8_SCHED; PG8_LDA(At, 0, 0); PG8_STAGE(PG8_SA(1, 1), a1 + hstep, voffA);
            PG8_WAIT_V(8); PG8_WAIT_L(0); PG8_BAR; PG8_MMA(0, 0, At, B0); PG8_MMA(0, 1, At, B1); PG8_BAR; PG8_SCHED;
            PG8_LDA(At, 0, 1); PG8_STAGE(PG8_SB(0, 0), b2, voffB); PG8_STAGE(PG8_SB(0, 1), b2 + hstep, voffB); PG8_STAGE(PG8_SA(0, 0), a2, voffA);
            PG8_WAIT_V(8); PG8_WAIT_L(0); PG8_BAR; PG8_MMA(1, 0, At, B0); PG8_MMA(1, 1, At, B1); PG8_BAR; PG8_SCHED;
            PG8_LDB(B0, 1, 0); PG8_LDB(B1, 1, 1); PG8_SCHED; PG8_LDA(At, 1, 0); PG8_STAGE(PG8_SA(0, 1), a2 + hstep, voffA);
            PG8_WAIT_V(8); PG8_WAIT_L(0); PG8_BAR; PG8_MMA(0, 0, At, B0); PG8_MMA(0, 1, At, B1); PG8_BAR; PG8_SCHED;
            PG8_LDA(At, 1, 1); PG8_STAGE(PG8_SB(1, 0), b3, voffB); PG8_STAGE(PG8_SB(1, 1), b3 + hstep, voffB); PG8_STAGE(PG8_SA(1, 0), a3, voffA);
            PG8_WAIT_V(8); PG8_WAIT_L(0); PG8_BAR; PG8_MMA(1, 0, At, B0); PG8_MMA(1, 1, At, B1); PG8_BAR; PG8_SCHED;
            } else {
            PG8_LDB(B0, 0, 0); PG8_SCHED; PG8_LDA(At, 0, 0); PG8_STAGE(PG8_SA(1, 1), a1 + hstep, voffA);
            PG8_WAIT_L(8); PG8_BAR; PG8_WAIT_L(0); PG8_MMA(0, 0, At, B0); PG8_BAR; PG8_SCHED;
            PG8_LDB(B1, 0, 1); PG8_STAGE(PG8_SB(0, 0), b2, voffB);
            PG8_BAR; PG8_WAIT_L(0); PG8_MMA(0, 1, At, B1); PG8_BAR;
            PG8_LDA(At, 0, 1); PG8_STAGE(PG8_SA(0, 0), a2, voffA);
            PG8_BAR; PG8_WAIT_L(0); PG8_MMA(1, 0, At, B0); PG8_BAR; PG8_SCHED;
            PG8_STAGE(PG8_SB(0, 1), b2 + hstep, voffB);
            PG8_WAIT_V(6); PG8_BAR; PG8_MMA(1, 1, At, B1); PG8_BAR;
            PG8_LDB(B0, 1, 0); PG8_SCHED; PG8_LDA(At, 1, 0); PG8_STAGE(PG8_SA(0, 1), a2 + hstep, voffA);
            PG8_WAIT_L(8); PG8_BAR; PG8_WAIT_L(0); PG8_MMA(0, 0, At, B0); PG8_BAR; PG8_SCHED;
            PG8_LDB(B1, 1, 1); PG8_STAGE(PG8_SB(1, 0), b3, voffB);
            PG8_BAR; PG8_WAIT_L(0); PG8_MMA(0, 1, At, B1); PG8_BAR;
            PG8_LDA(At, 1, 1); PG8_STAGE(PG8_SA(1, 0), a3, voffA);
            PG8_BAR; PG8_WAIT_L(0); PG8_MMA(1, 0, At, B0); PG8_BAR; PG8_SCHED;
            PG8_STAGE(PG8_SB(1, 1), b3 + hstep, voffB);
            PG8_WAIT_V(6); PG8_BAR; PG8_MMA(1, 1, At, B1); PG8_BAR;
            }
        }
        if constexpr (ALIGN_EPI) { if (wr == 0) PG8_BAR; }
        if constexpr (!Epi::AFTER_DRAIN) { E(acc, cur, wr, wc, fr, fq); S.done(cur); }
        if (!has_next) break;
#pragma unroll
        for (int a = 0; a < 2; ++a)
#pragma unroll
            for (int b = 0; b < 2; ++b)
#pragma unroll
                for (int m = 0; m < 4; ++m)
#pragma unroll
                    for (int n = 0; n < 2; ++n) acc[a][b][m][n] = (f32x4){0.f, 0.f, 0.f, 0.f};
        cur = nxt; cA = nA; cB = nB; ++ui;
        if constexpr (ALIGN_EPI) { if (wr == 1) PG8_BAR; }
    }
    PG8_WAIT_V(0);
    if constexpr (!ALIGN_EPI) { if (wr == 0) PG8_BAR; }
    PG8_BAR;
    if constexpr (Epi::AFTER_DRAIN) { E.fused(acc, cur, wr, wc, fr, fq, lds, wid, lane); S.done(cur); }
#undef PG8_SA
#undef PG8_SB
#undef PG8_STAGE
#undef PG8_LDA
#undef PG8_LDB
#undef PG8_MMA
#undef PG8_WAIT_V
#undef PG8_WAIT_L
#undef PG8_BAR
#undef PG8_SCHED
}
}

#ifndef EN_MASK
#define EN_MASK 0xff
#endif
#define EN(x) ((EN_MASK >> (x)) & 1)
#ifndef DUP_MASK
#define DUP_MASK 0
#endif
#define DUP(x) (((DUP_MASK >> (x)) & 1) ? 2 : 1)
#ifndef MK_MULTI
#define MK_MULTI 0
#endif
#define LAS __attribute__((address_space(3)))
typedef LAS unsigned char* ldsp;
typedef unsigned short bf16_t;
typedef short bf16x8 __attribute__((ext_vector_type(8)));
typedef short s16x4 __attribute__((ext_vector_type(4)));
typedef short v4i16_t __attribute__((ext_vector_type(4)));
typedef float f32x4 __attribute__((ext_vector_type(4)));
typedef float f32x16 __attribute__((ext_vector_type(16)));
typedef unsigned u32x4 __attribute__((ext_vector_type(4)));
typedef unsigned u32x2 __attribute__((ext_vector_type(2)));
typedef __bf16 bf16x2_t __attribute__((ext_vector_type(2)));
typedef float f32x2_t __attribute__((ext_vector_type(2)));

constexpr int MTOK = 98304, DM = 1024, NPROMPT = 32768, SEQ_P = 16384, SEQ_S = 2048;
constexpr size_t MiB = 1u << 20;
constexpr size_t WS_WA = 1 * MiB, WA_SZ = 5 * MiB;
constexpr size_t WS_WAO = 11 * MiB, WO_SZ = 2 * MiB;
constexpr size_t WS_WM = 15 * MiB, WM_SZ = 4352 * 1024 * 2;
constexpr size_t WS_WMO = 32 * MiB;
constexpr size_t WS_ROPE = 36 * MiB;
constexpr size_t WS_GATES = 40 * MiB;
constexpr size_t WS_R0 = 48 * MiB, RSZ = 192 * MiB;
constexpr size_t WS_GV = WS_R0 + 5 * RSZ;
constexpr size_t WS_SS = WS_GV + 10 * MiB;
constexpr size_t WS_END = WS_SS + 3 * MiB;
constexpr float SS_SCALE = 16777216.f, SS_INV = 1.f / (16777216.f * 1024.f);
typedef unsigned long long u64_t;
constexpr int LDS_BYTES = 163840;
constexpr int NPHASE = 18;
constexpr float LOG2E = 1.4426950408889634f;

struct Args { const float* in[11]; float* out; unsigned char* ws; int ph_lo, ph_hi; };

__device__ __forceinline__ unsigned pk2(float lo, float hi) { f32x2_t v = {lo, hi}; bf16x2_t b = __builtin_convertvector(v, bf16x2_t); return __builtin_bit_cast(unsigned, b); }
__device__ __forceinline__ float bf_lo(unsigned w) { return __builtin_bit_cast(float, w << 16); }
__device__ __forceinline__ float bf_hi(unsigned w) { return __builtin_bit_cast(float, w & 0xffff0000u); }
__device__ __forceinline__ float bf_s(short s) { return __builtin_bit_cast(float, ((unsigned)(unsigned short)s) << 16); }
__device__ __forceinline__ s16x4 lds_tr(ldsp p) { return __builtin_bit_cast(s16x4, __builtin_amdgcn_ds_read_tr16_b64_v4i16((LAS v4i16_t*)p)); }
__device__ __forceinline__ bf16x8 cat8(s16x4 lo, s16x4 hi) { bf16x8 r; r[0] = lo[0]; r[1] = lo[1]; r[2] = lo[2]; r[3] = lo[3]; r[4] = hi[0]; r[5] = hi[1]; r[6] = hi[2]; r[7] = hi[3]; return r; }
__device__ __forceinline__ bf16x8 pack8(float a0, float a1, float a2, float a3, float a4, float a5, float a6, float a7) {
    u32x4 w; w.x = pk2(a0, a1); w.y = pk2(a2, a3); w.z = pk2(a4, a5); w.w = pk2(a6, a7); return __builtin_bit_cast(bf16x8, w); }
__device__ __forceinline__ float fsigmoid(float x) { return __builtin_amdgcn_rcpf(1.f + __expf(-x)); }
#define MFMA32(a, b, c) __builtin_amdgcn_mfma_f32_32x32x16_bf16((a), (b), (c), 0, 0, 0)

namespace pg8 {
struct EpiAttnIn {
    static constexpr bool PERM = true, AFTER_DRAIN = false;
    bf16_t *Q, *K, *V, *Z; const float* rope; const u64_t* ss;
    __device__ __forceinline__ void operator()(const f32x4 (&acc)[2][2][4][2], const Unit& u, int wr, int wc, int fr, int fq) const {
        const int row0 = u.pm * BM + wr * 64 + fr, pn = u.pn;
        const int colb = pn * BM + wc * 32 + 8 * fq;
        float rsv[8];
#pragma unroll
        for (int i = 0; i < 8; ++i) rsv[i] = (float)ss[row0 + (i >> 2) * HALF + (i & 3) * 16];
#pragma unroll
        for (int i = 0; i < 8; ++i) rsv[i] = rsqrtf(rsv[i] * SS_INV + 1e-6f);
        if (pn < 5) {
            f32x4 cs[2][4];
            const int cofs = ((colb & 63) >> 1) * 2;
#define ROPE_LD(i, buf) do { const int row_ = row0 + ((i) >> 2) * HALF + ((i) & 3) * 16; const int pos_ = row_ < NPROMPT ? (row_ & (SEQ_P - 1)) : (row_ & (SEQ_S - 1)); \
            const float* p_ = rope + (size_t)pos_ * 64 + cofs; cs[buf][0] = *(const f32x4*)p_; cs[buf][1] = *(const f32x4*)(p_ + 4); } while (0)
            ROPE_LD(0, 0);
#pragma unroll
            for (int i = 0; i < 8; ++i) {
                if (i + 1 < 8) ROPE_LD(i + 1, (i + 1) & 1);
                const int ai = i >> 2, mm = i & 3, row = row0 + ai * HALF + mm * 16;
                const float rs = rsv[i];
                const f32x4 c01 = cs[i & 1][0], c23 = cs[i & 1][1];
#pragma unroll
                for (int bj = 0; bj < 2; ++bj) {
                    const int col = colb + bj * HALF;
                    const f32x4 v0 = acc[ai][bj][mm][0] * rs, v1 = acc[ai][bj][mm][1] * rs;
                    f32x4 o0, o1;
                    o0[0] = v0[0] * c01[0] - v0[1] * c01[1]; o0[1] = v0[1] * c01[0] + v0[0] * c01[1];
                    o0[2] = v0[2] * c01[2] - v0[3] * c01[3]; o0[3] = v0[3] * c01[2] + v0[2] * c01[3];
                    o1[0] = v1[0] * c23[0] - v1[1] * c23[1]; o1[1] = v1[1] * c23[0] + v1[0] * c23[1];
                    o1[2] = v1[2] * c23[2] - v1[3] * c23[3]; o1[3] = v1[3] * c23[2] + v1[2] * c23[3];
                    bf16_t* dst = pn < 4 ? Q + (size_t)row * 1024 + col : K + (size_t)row * 256 + (col - 1024);
                    u32x4 w; w.x = cvt_pk_bf16(o0[0], o0[1]); w.y = cvt_pk_bf16(o0[2], o0[3]); w.z = cvt_pk_bf16(o1[0], o1[1]); w.w = cvt_pk_bf16(o1[2], o1[3]);
                    *(u32x4*)dst = w;
                }
            }
#undef ROPE_LD
        } else {
#pragma unroll
            for (int i = 0; i < 8; ++i) {
                const int ai = i >> 2, mm = i & 3, row = row0 + ai * HALF + mm * 16;
                const float rs = rsv[i];
#pragma unroll
                for (int bj = 0; bj < 2; ++bj) {
                    const int col = colb + bj * HALF;
                    f32x4 v0 = acc[ai][bj][mm][0] * rs, v1 = acc[ai][bj][mm][1] * rs;
                    bf16_t* dst;
                    if (pn == 5) dst = V + (size_t)row * 256 + (col - 1280);
                    else {
#pragma unroll
                        for (int e = 0; e < 4; ++e) { v0[e] = v0[e] * fsigmoid(v0[e]); v1[e] = v1[e] * fsigmoid(v1[e]); }
                        dst = Z + (size_t)row * 1024 + (col - 1536);
                    }
                    u32x4 w; w.x = cvt_pk_bf16(v0[0], v0[1]); w.y = cvt_pk_bf16(v0[2], v0[3]); w.z = cvt_pk_bf16(v1[0], v1[1]); w.w = cvt_pk_bf16(v1[2], v1[3]);
                    *(u32x4*)dst = w;
                }
            }
        }
    }
};
struct EpiMlstmIn {
    static constexpr bool PERM = true, AFTER_DRAIN = false;
    bf16_t *Q, *K, *V, *G; float* gates; const float* bias; const u64_t* ss;
    __device__ __forceinline__ void operator()(const f32x4 (&acc)[2][2][4][2], const Unit& u, int wr, int wc, int fr, int fq) const {
        const int row0 = u.pm * BM + wr * 64 + fr, pn = u.pn;
        float rsv[8];
#pragma unroll
        for (int i = 0; i < 8; ++i) rsv[i] = (float)ss[row0 + (i >> 2) * HALF + (i & 3) * 16];
#pragma unroll
        for (int i = 0; i < 8; ++i) rsv[i] = rsqrtf(rsv[i] * SS_INV + 1e-6f);
        f32x4 bia0 = {0.f, 0.f, 0.f, 0.f}, bia1 = {0.f, 0.f, 0.f, 0.f};
        if (pn == 16 && wc == 0 && fq < 2) { bia0 = *(const f32x4*)(bias + 8 * fq); bia1 = *(const f32x4*)(bias + 8 * fq + 4); }
#pragma unroll
        for (int ai = 0; ai < 2; ++ai)
#pragma unroll
            for (int m = 0; m < 4; ++m) {
                const int row = row0 + ai * HALF + m * 16;
                const float rs = rsv[ai * 4 + m];
#pragma unroll
                for (int bj = 0; bj < 2; ++bj) {
                    const int col = pn * BM + bj * HALF + wc * 32 + 8 * fq;
                    const f32x4 v0 = acc[ai][bj][m][0] * rs, v1 = acc[ai][bj][m][1] * rs;
                    if (pn < 8) {
                        bf16_t* dst = pn < 2 ? Q + (size_t)row * 512 + col : (pn < 4 ? K + (size_t)row * 512 + (col - 512) : V + (size_t)row * 1024 + (col - 1024));
                        u32x4 w; w.x = cvt_pk_bf16(v0[0], v0[1]); w.y = cvt_pk_bf16(v0[2], v0[3]); w.z = cvt_pk_bf16(v1[0], v1[1]); w.w = cvt_pk_bf16(v1[2], v1[3]);
                        *(u32x4*)dst = w;
                    } else if (pn < 16) {
                        const float g0 = v0[1] * __builtin_amdgcn_rcpf((1.f + __expf(-v0[0])) * (1.f + __expf(-v0[1])));
                        const float g1 = v0[3] * __builtin_amdgcn_rcpf((1.f + __expf(-v0[2])) * (1.f + __expf(-v0[3])));
                        const float g2 = v1[1] * __builtin_amdgcn_rcpf((1.f + __expf(-v1[0])) * (1.f + __expf(-v1[1])));
                        const float g3 = v1[3] * __builtin_amdgcn_rcpf((1.f + __expf(-v1[2])) * (1.f + __expf(-v1[3])));
                        u32x2 w; w.x = cvt_pk_bf16(g0, g1); w.y = cvt_pk_bf16(g2, g3);
                        *(u32x2*)(G + (size_t)row * 1024 + ((col - 2048) >> 1)) = w;
                    } else {
                        const int gc = col - 4096;
                        if (gc < 16) {
                            *(f32x4*)(gates + (size_t)row * 16 + gc) = v0 + bia0;
                            *(f32x4*)(gates + (size_t)row * 16 + gc + 4) = v1 + bia1;
                        }
                    }
                }
            }
    }
};
struct EpiResid {
    static constexpr bool PERM = true, AFTER_DRAIN = false;
    const float* in0; const float* in1;
    float* out; bf16_t* xb; u64_t* ss;
    __device__ __forceinline__ void operator()(const f32x4 (&acc)[2][2][4][2], const Unit& u, int wr, int wc, int fr, int fq) const {
        const int row0 = u.pm * BM + wr * 64 + fr;
        const size_t coff = (size_t)u.pn * BM + wc * 32 + 8 * fq;
        f32x4 pre[3][4];
#define RES_LD(i, buf) do { const int row_ = row0 + ((i) >> 2) * HALF + ((i) & 3) * 16; const size_t off_ = (size_t)row_ * 1024 + coff; \
        const float* bp_ = in0 ? (row_ < NPROMPT ? in0 + off_ : in1 + (off_ - (size_t)NPROMPT * 1024)) : out + off_; \
        pre[buf][0] = *(const f32x4*)(bp_); pre[buf][1] = *(const f32x4*)(bp_ + 4); pre[buf][2] = *(const f32x4*)(bp_ + HALF); pre[buf][3] = *(const f32x4*)(bp_ + HALF + 4); } while (0)
        RES_LD(0, 0); RES_LD(1, 1);
#pragma unroll
        for (int i = 0; i < 8; ++i) {
            if (i + 2 < 8) RES_LD(i + 2, (i + 2) % 3);
            const int ai = i >> 2, mm = i & 3, row = row0 + ai * HALF + mm * 16;
            const size_t off = (size_t)row * 1024 + coff;
            float sq = 0.f;
#pragma unroll
            for (int bj = 0; bj < 2; ++bj) {
                const f32x4 x0 = pre[i % 3][2 * bj] + acc[ai][bj][mm][0], x1 = pre[i % 3][2 * bj + 1] + acc[ai][bj][mm][1];
                *(f32x4*)(out + off + bj * HALF) = x0; *(f32x4*)(out + off + bj * HALF + 4) = x1;
                if (ss) {
                    u32x4 w; w.x = cvt_pk_bf16(x0[0], x0[1]); w.y = cvt_pk_bf16(x0[2], x0[3]); w.z = cvt_pk_bf16(x1[0], x1[1]); w.w = cvt_pk_bf16(x1[2], x1[3]);
                    *(u32x4*)(xb + off + bj * HALF) = w;
                    sq += x0[0] * x0[0] + x0[1] * x0[1] + x0[2] * x0[2] + x0[3] * x0[3] + x1[0] * x1[0] + x1[1] * x1[1] + x1[2] * x1[2] + x1[3] * x1[3];
                }
            }
            if (ss) {
                sq += __shfl_xor(sq, 16); sq += __shfl_xor(sq, 32);
                if (fq == 0) atomicAdd(ss + row, (u64_t)(sq * SS_SCALE + 0.5f));
            }
        }
#undef RES_LD
    }
};
}

__device__ __forceinline__ void prep_phase(const Args& a, ldsp lds, int G) {
    const int tid = opaque_tid();
    LAS float* tile = (LAS float*)lds;
    for (int it = opaque_bid(); it < 4480; it += G) {
        const int j = it / 2240; int r = it % 2240; int wt;
        if (r < 640) wt = 0; else if (r < 896) { wt = 1; r -= 640; } else if (r < 1984) { wt = 2; r -= 896; } else { wt = 3; r -= 1984; }
        const int nt = r >> 4, kt = r & 15;
        const float* W; int Nsrc; const float* g = nullptr; bf16_t* dst;
        if (wt == 0) { W = a.in[3] + (size_t)j * 1024 * 2560; Nsrc = 2560; g = a.in[2] + (2 * j) * 1024; dst = (bf16_t*)(a.ws + WS_WA + j * WA_SZ); }
        else if (wt == 1) { W = a.in[5] + (size_t)j * 1024 * 1024; Nsrc = 1024; dst = (bf16_t*)(a.ws + WS_WAO + j * WO_SZ); }
        else if (wt == 2) { W = a.in[6] + (size_t)j * 1024 * 4112; Nsrc = 4112; g = a.in[2] + (2 * j + 1) * 1024; dst = (bf16_t*)(a.ws + WS_WM + j * WM_SZ); }
        else { W = a.in[9] + (size_t)j * 1024 * 1024; Nsrc = 1024; dst = (bf16_t*)(a.ws + WS_WMO + j * WO_SZ); }
        const int nn = tid & 63, np = nt * 64 + nn;
        int src = np; float sc = 1.f;
        if (wt == 0) {
            if (np < 1280) { const int base = np < 1024 ? 0 : 1024, m = np - base; src = base + (m & ~63) + ((m & 63) >> 1) + 32 * (m & 1); if (np < 1024) sc = 0.125f * LOG2E; }
        } else if (wt == 2) {
            if (np < 2048) { if (np >= 512 && np < 1024) sc = 0.08838834764831845f; }
            else if (np < 4096) { const int jj = np - 2048; src = (jj & 1) ? 3072 + (jj >> 1) : 2048 + (jj >> 1); }
            else if (np >= 4112) src = -1;
        }
#pragma unroll
        for (int p = 0; p < 8; ++p) {
            const int kk = p * 8 + (tid >> 6), k = kt * 64 + kk; float v = 0.f;
            if (src >= 0) { v = W[(size_t)k * Nsrc + src] * sc; if (g) v *= g[k]; }
            tile[kk * 65 + nn] = v;
        }
        __syncthreads();
        {
            const int n2 = tid >> 3, kc = tid & 7;
            const float v0 = tile[(kc * 8 + 0) * 65 + n2], v1 = tile[(kc * 8 + 1) * 65 + n2], v2 = tile[(kc * 8 + 2) * 65 + n2], v3 = tile[(kc * 8 + 3) * 65 + n2];
            const float v4 = tile[(kc * 8 + 4) * 65 + n2], v5 = tile[(kc * 8 + 5) * 65 + n2], v6 = tile[(kc * 8 + 6) * 65 + n2], v7 = tile[(kc * 8 + 7) * 65 + n2];
            u32x4 w; w.x = pk2(v0, v1); w.y = pk2(v2, v3); w.z = pk2(v4, v5); w.w = pk2(v6, v7);
            *(u32x4*)(dst + (size_t)(nt * 64 + n2) * 1024 + kt * 64 + kc * 8) = w;
        }
        __syncthreads();
    }
    float* rope = (float*)(a.ws + WS_ROPE);
    for (int idx = opaque_bid() * 512 + tid; idx < 16384 * 32; idx += G * 512) {
        const int pos = idx >> 5, i = idx & 31;
        const float inv = expf((-9.210340371976184f * (float)i) / 32.0f);
        const float ang = (float)pos * inv;
        double rev = (double)ang * 0.15915494309189535; rev -= floor(rev);
        const float fr = (float)rev;
        rope[2 * idx] = __builtin_amdgcn_cosf(fr); rope[2 * idx + 1] = __builtin_amdgcn_sinf(fr);
    }
}

__device__ __forceinline__ void norm_phase(const Args& a, int mode, int G) {
    const int tid_ = opaque_tid(); const int lane = tid_ & 63, wave = tid_ >> 6;
    bf16_t* xb = (bf16_t*)(a.ws + WS_R0);
    u64_t* ss0 = (u64_t*)(a.ws + WS_SS);
    if (mode == 0) { for (int i = opaque_bid() * 512 + tid_; i < 3 * MTOK; i += G * 512) ss0[MTOK + i] = 0ull; }
    for (int row = opaque_bid() * 8 + wave; row < MTOK; row += G * 8) {
        const float* src = mode == 0 ? (row < NPROMPT ? a.in[0] + (size_t)row * DM : a.in[1] + (size_t)(row - NPROMPT) * DM) : a.out + (size_t)row * DM;
        const f32x4 v0 = __builtin_nontemporal_load((const f32x4*)src + lane), v1 = __builtin_nontemporal_load((const f32x4*)src + lane + 64), v2 = __builtin_nontemporal_load((const f32x4*)src + lane + 128), v3 = __builtin_nontemporal_load((const f32x4*)src + lane + 192);
        float ss = v0[0] * v0[0] + v0[1] * v0[1] + v0[2] * v0[2] + v0[3] * v0[3] + v1[0] * v1[0] + v1[1] * v1[1] + v1[2] * v1[2] + v1[3] * v1[3]
                 + v2[0] * v2[0] + v2[1] * v2[1] + v2[2] * v2[2] + v2[3] * v2[3] + v3[0] * v3[0] + v3[1] * v3[1] + v3[2] * v3[2] + v3[3] * v3[3];
#pragma unroll
        for (int o = 32; o >= 1; o >>= 1) ss += __shfl_xor(ss, o);
        if (mode == 2) {
            const float rs = rsqrtf(ss * (1.f / 1024.f) + 1e-6f);
            const f32x4* g = (const f32x4*)a.in[10];
            f32x4* o = (f32x4*)(a.out + (size_t)row * DM);
            __builtin_nontemporal_store(v0 * rs * g[lane], o + lane); __builtin_nontemporal_store(v1 * rs * g[lane + 64], o + lane + 64); __builtin_nontemporal_store(v2 * rs * g[lane + 128], o + lane + 128); __builtin_nontemporal_store(v3 * rs * g[lane + 192], o + lane + 192);
        } else {
            u32x2* o = (u32x2*)(xb + (size_t)row * DM);
            u32x2 w;
            w.x = pk2(v0[0], v0[1]); w.y = pk2(v0[2], v0[3]); o[lane] = w;
            w.x = pk2(v1[0], v1[1]); w.y = pk2(v1[2], v1[3]); o[lane + 64] = w;
            w.x = pk2(v2[0], v2[1]); w.y = pk2(v2[2], v2[3]); o[lane + 128] = w;
            w.x = pk2(v3[0], v3[1]); w.y = pk2(v3[2], v3[3]); o[lane + 192] = w;
            if (lane == 0) ss0[row] = (u64_t)(ss * SS_SCALE + 0.5f);
        }
    }
}

constexpr int KRS = 144;
__device__ __forceinline__ void attn_phase(const Args& a, ldsp lds, int j, int G) {
    const int tid = opaque_tid(), lane = tid & 63, wave = tid >> 6, l31 = lane & 31, h = lane >> 5;
    const int blk = (lane >> 4) & 1, qsub = (lane & 15) >> 2, p4 = lane & 3;
    const bf16_t* Q = (const bf16_t*)(a.ws + WS_R0 + 1 * RSZ);
    const bf16_t* K = (const bf16_t*)(a.ws + WS_R0 + 2 * RSZ);
    const bf16_t* V = (const bf16_t*)(a.ws + WS_R0 + 2 * RSZ + 48 * MiB);
    const bf16_t* Z = (const bf16_t*)(a.ws + WS_R0 + 3 * RSZ);
    bf16_t* O = (bf16_t*)(a.ws + WS_R0 + 4 * RSZ);
    const float* sink = a.in[4] + j * 16;
    ldsp Ks = lds, Vs = lds + 384 * KRS;
    for (int u = opaque_bid(); u < 3072; u += G) {
        const int g = u & 3, qb = u >> 2, q0 = qb * 128;
        int ss, se;
        if (q0 < NPROMPT) { ss = q0 & ~(SEQ_P - 1); se = ss + SEQ_P; } else { ss = q0 & ~(SEQ_S - 1); se = ss + SEQ_S; }
        const int r = wave >> 1, qtA = 2 * (wave & 1), head = 4 * g + r, r0 = q0 + 32 * qtA;
        const bf16_t* qpa = Q + (size_t)(r0 + l31) * 1024 + head * 64 + 8 * h;
        const bf16_t* qpb = qpa + 32 * 1024;
        const bf16x8 QA0 = *(const bf16x8*)(qpa), QA1 = *(const bf16x8*)(qpa + 16), QA2 = *(const bf16x8*)(qpa + 32), QA3 = *(const bf16x8*)(qpa + 48);
        const bf16x8 QB0 = *(const bf16x8*)(qpb), QB1 = *(const bf16x8*)(qpb + 16), QB2 = *(const bf16x8*)(qpb + 32), QB3 = *(const bf16x8*)(qpb + 48);
        __syncthreads();
#pragma unroll
        for (int i = 0; i < 6; ++i) {
            const int c = tid + 512 * i, r = c >> 3, ch = c & 7, grow = q0 - 128 + r;
            u32x4 kv = {0u, 0u, 0u, 0u}, vv = {0u, 0u, 0u, 0u};
            if (grow >= ss && grow < se) { kv = *(const u32x4*)(K + (size_t)grow * 256 + g * 64 + ch * 8); vv = *(const u32x4*)(V + (size_t)grow * 256 + g * 64 + ch * 8); }
            *(LAS u32x4*)(Ks + r * KRS + ch * 16) = kv; *(LAS u32x4*)(Vs + r * KRS + ch * 16) = vv;
        }
        __syncthreads();
        {
            const float m0 = sink[head] * LOG2E;
            float mA = m0, mB = m0, lA = h == 0 ? 1.f : 0.f, lB = lA;
            f32x16 OA0, OA1, OB0, OB1;
#pragma unroll
            for (int i = 0; i < 16; ++i) { OA0[i] = 0.f; OA1[i] = 0.f; OB0[i] = 0.f; OB1[i] = 0.f; }
            for (int kt = 0; kt < 10; ++kt) {
                const int kb = 32 * qtA + 32 * kt, kg = q0 - 128 + kb;
                if (kg < ss || kg >= se) continue;
                ldsp kp = Ks + (kb + l31) * KRS + 16 * h;
                const bf16x8 K0 = *(const LAS bf16x8*)(kp), K1 = *(const LAS bf16x8*)(kp + 32), K2 = *(const LAS bf16x8*)(kp + 64), K3 = *(const LAS bf16x8*)(kp + 96);
                ldsp vb = Vs + (kb + 4 * h + qsub) * KRS + (16 * blk + 4 * p4) * 2;
                const bf16x8 V00 = cat8(lds_tr(vb), lds_tr(vb + 8 * KRS)), V01 = cat8(lds_tr(vb + 64), lds_tr(vb + 8 * KRS + 64));
                const bf16x8 V10 = cat8(lds_tr(vb + 16 * KRS), lds_tr(vb + 24 * KRS)), V11 = cat8(lds_tr(vb + 16 * KRS + 64), lds_tr(vb + 24 * KRS + 64));
#define ATT_JOB(QQ0, QQ1, QQ2, QQ3, MM, LL, OO0, OO1, KTJ) do { \
                    f32x16 s; \
                    _Pragma("unroll") for (int i = 0; i < 16; ++i) s[i] = 0.f; \
                    s = MFMA32(K0, QQ0, s); s = MFMA32(K1, QQ1, s); s = MFMA32(K2, QQ2, s); s = MFMA32(K3, QQ3, s); \
                    if ((KTJ) == 0 || (KTJ) == 8) { \
                        _Pragma("unroll") for (int i = 0; i < 16; ++i) { const int kk = (i & 3) + 8 * (i >> 2) + 4 * h; \
                            const bool valid = (KTJ) == 0 ? (kk >= l31) : (kk <= l31); if (!valid) s[i] = -INFINITY; } } \
                    float mx = s[0]; \
                    _Pragma("unroll") for (int i = 1; i < 16; ++i) mx = fmaxf(mx, s[i]); \
                    mx = fmaxf(mx, __shfl_xor(mx, 32)); \
                    if (__any(mx > MM + 8.f)) {            \
                        const float mn = fmaxf(MM, mx), alpha = __builtin_amdgcn_exp2f(MM - mn); MM = mn; LL *= alpha; \
                        _Pragma("unroll") for (int i = 0; i < 16; ++i) { OO0[i] *= alpha; OO1[i] *= alpha; } } \
                    float ps = 0.f; \
                    _Pragma("unroll") for (int i = 0; i < 16; ++i) { s[i] = __builtin_amdgcn_exp2f(s[i] - MM); ps += s[i]; } \
                    LL += ps; \
                    const bf16x8 P0 = pack8(s[0], s[1], s[2], s[3], s[4], s[5], s[6], s[7]); \
                    const bf16x8 P1 = pack8(s[8], s[9], s[10], s[11], s[12], s[13], s[14], s[15]); \
                    OO0 = MFMA32(V00, P0, OO0); OO1 = MFMA32(V01, P0, OO1); OO0 = MFMA32(V10, P1, OO0); OO1 = MFMA32(V11, P1, OO1); } while (0)
                if (kt < 9) ATT_JOB(QA0, QA1, QA2, QA3, mA, lA, OA0, OA1, kt);
                if (kt > 0) ATT_JOB(QB0, QB1, QB2, QB3, mB, lB, OB0, OB1, kt - 1);
#undef ATT_JOB
            }
#define ATT_OUT(LL, OO0, OO1, ROWOFF) do { \
                LL += __shfl_xor(LL, 32); \
                const float inv = 1.f / LL; \
                const size_t orow = (size_t)(r0 + (ROWOFF) + l31) * 1024 + head * 64; \
                _Pragma("unroll") for (int gq = 0; gq < 4; ++gq) { \
                    const int d0 = 8 * gq + 4 * h; \
                    const u32x2 z0 = *(const u32x2*)(Z + orow + d0), z1 = *(const u32x2*)(Z + orow + 32 + d0); \
                    u32x2 w; \
                    w.x = pk2(OO0[4 * gq] * inv * bf_lo(z0.x), OO0[4 * gq + 1] * inv * bf_hi(z0.x)); w.y = pk2(OO0[4 * gq + 2] * inv * bf_lo(z0.y), OO0[4 * gq + 3] * inv * bf_hi(z0.y)); \
                    *(u32x2*)(O + orow + d0) = w; \
                    w.x = pk2(OO1[4 * gq] * inv * bf_lo(z1.x), OO1[4 * gq + 1] * inv * bf_hi(z1.x)); w.y = pk2(OO1[4 * gq + 2] * inv * bf_lo(z1.y), OO1[4 * gq + 3] * inv * bf_hi(z1.y)); \
                    *(u32x2*)(O + orow + 32 + d0) = w; } } while (0)
            ATT_OUT(lA, OA0, OA1, 0);
            ATT_OUT(lB, OB0, OB1, 32);
#undef ATT_OUT
        }
    }
}

constexpr int GV_STRIDE = 208;
__device__ __forceinline__ void gatescan_phase(const Args& a, int G) {
    const int tid_ = opaque_tid(); const int lane = tid_ & 63, wave = tid_ >> 6;
    const float* gates = (const float*)(a.ws + WS_GATES);
    float* GV = (float*)(a.ws + WS_GV);
    for (int task = opaque_bid() * 8 + wave; task < 1536 * 8; task += G * 8) {
        const int cgl = task >> 3, dh = task & 7, dir = dh >> 2, head = dh & 3;
        const int jx = dir ? 63 - lane : lane;
        const float* gp = gates + ((size_t)cgl * 64 + jx) * 16 + dir * 8 + head;
        const float gi = gp[0], gf = gp[4];
        float x = fminf(gf, 0.f) - __logf(1.f + __expf(-fabsf(gf)));
#pragma unroll
        for (int d = 1; d < 64; d <<= 1) { const float t = __shfl_up(x, d); if (lane >= d) x += t; }
        const float aa = gi - x; float pmx = aa;
#pragma unroll
        for (int d = 1; d < 64; d <<= 1) { const float t = __shfl_up(pmx, d); if (lane >= d) pmx = fmaxf(pmx, t); }
        float* o = GV + (size_t)task * GV_STRIDE;
        const float pm_all = __shfl(pmx, 63);
        o[jx] = x; o[64 + jx] = __expf(aa - pm_all); o[128 + jx] = pmx;
        if (lane == 63) { o[192] = x; o[193] = pmx; }
    }
}

constexpr int QRS = 272, VRS = 144;
constexpr int ML_XB = 141952, ML_XP = ML_XB, ML_XQ = ML_XB + 9216, ML_XS = ML_XQ + 8192, ML_XF = ML_XS + 1024;
constexpr int ML_Q = 0, ML_K = 34816, ML_V = 69632, ML_C = 88064, ML_CSZ = 26112  , ML_GB = 140288, ML_GBSZ = 832;
__device__ __forceinline__ void hn_phase(const Args& a, int j, int row_lo, int row_hi, int bidx, int nblk);
__device__ __forceinline__ void mlstm_phase(const Args& a, ldsp lds, int j, int G) {
    const int tid = opaque_tid(), lane = tid & 63, wave = __builtin_amdgcn_readfirstlane(tid >> 6), l31 = lane & 31, h = lane >> 5;
    const int blk = (lane >> 4) & 1, qsub = (lane & 15) >> 2, p4 = lane & 3;
    const bf16_t* Qg = (const bf16_t*)(a.ws + WS_R0 + 1 * RSZ);
    const bf16_t* Kg = (const bf16_t*)(a.ws + WS_R0 + 1 * RSZ + 96 * MiB);
    const bf16_t* Vg = (const bf16_t*)(a.ws + WS_R0 + 2 * RSZ);
    const float* GV = (const float*)(a.ws + WS_GV);
    int first, stride;
    if (G >= 128) { first = opaque_bid(); stride = first < 64 ? (1 << 28) : G - 64; } else { first = opaque_bid(); stride = G; }
#define ML_LD1(k, dq, dk) do { const unsigned o_ = (unsigned)(((tid2 + 256 * (k)) >> 4) * 512 + ((tid2 + 256 * (k)) & 15) * 8); dq = *(const u32x4*)(qu_ + o_); dk = *(const u32x4*)(ku_ + o_); } while (0)
#define ML_ST1(k, dq, dk) do { const int c = tid2 + 256 * (k), r = c >> 4, ch = c & 15; *(LAS u32x4*)(Qw + r * QRS + ch * 16) = dq; *(LAS u32x4*)(Kw + r * QRS + ch * 16) = dk; } while (0)
#define ML_LOAD(chunk) do { const size_t tok0 = base + (size_t)(chunk) * 64;     \
            const bf16_t* qu_ = Qg + tok0 * 512 + head * 128; const bf16_t* ku_ = Kg + tok0 * 512 + head * 128; const bf16_t* vu_ = Vg + tok0 * 1024 + head * 256 + sl * 64; \
            ML_LD1(0, rq0, rk0); ML_LD1(1, rq1, rk1); ML_LD1(2, rq2, rk2); ML_LD1(3, rq3, rk3); \
            { const unsigned o_ = (unsigned)((tid2 >> 3) * 1024 + (tid2 & 7) * 8); pv0 = *(const u32x4*)(vu_ + o_); pv1 = *(const u32x4*)(vu_ + (o_ + 32u * 1024u)); } \
            if (tid2 < 52) pg = *(const f32x4*)(gvb + (size_t)(chunk) * (8 * GV_STRIDE) + (unsigned)(tid2 * 4)); } while (0)
#define ML_STORE(par) do { ldsp Qw = lds + ML_Q + (par) * 17408, Kw = lds + ML_K + (par) * 17408, Vw = lds + ML_V + (par) * 9216; \
            ML_ST1(0, rq0, rk0); ML_ST1(1, rq1, rk1); ML_ST1(2, rq2, rk2); ML_ST1(3, rq3, rk3); \
            { const int r = tid2 >> 3, ch = tid2 & 7; *(LAS u32x4*)(Vw + r * VRS + ch * 16) = pv0; *(LAS u32x4*)(Vw + (32 + r) * VRS + ch * 16) = pv1; } \
            if (tid2 < 52) *(LAS f32x4*)(lds + ML_GB + (par) * ML_GBSZ + tid2 * 16) = pg; } while (0)
    for (int it = first; it < 1088; it += stride) {
        int seq, NC; size_t base; int t2 = it;
        if (it < 64) { NC = 256; seq = it >> 5; base = (size_t)seq * SEQ_P; } else { t2 = it - 64; NC = 32; seq = t2 >> 5; base = (size_t)NPROMPT + (size_t)seq * SEQ_S; }
        const int head = (t2 >> 3) & 3, dir = (t2 >> 2) & 1, sl = t2 & 3;
        bf16_t* Hout = (bf16_t*)(a.ws + WS_R0 + (dir ? 4 * RSZ : 0));
        __syncthreads();
        for (int i = tid; i < 2 * ML_CSZ / 16; i += 512) *(LAS u32x4*)(lds + ML_C + i * 16) = (u32x4){0u, 0u, 0u, 0u};
        if (tid < 16) ((LAS unsigned*)(lds + ML_XF))[tid] = 0u;
        const float* gvb = GV + ((base >> 6) * 8 + dir * 4 + head) * GV_STRIDE;
        if (wave < 4) {
            const int vt = wave & 1, tt = wave >> 1, t = 32 * tt + l31;
            float mc = -1e30f;
            ldsp XP = lds + ML_XP + tt * 4608, XQ = lds + ML_XQ + tt * 4096;
            LAS float* XS = (LAS float*)(lds + ML_XS + tt * 512);
            volatile LAS unsigned* flagP = (volatile LAS unsigned*)(lds + ML_XF) + tt;
            volatile LAS unsigned* flagQ = (volatile LAS unsigned*)(lds + ML_XF) + 2 + tt;
            for (int i = 0; i < NC; ++i) {
                const int chunk = dir ? NC - 1 - i : i, par = i & 1;
                __syncthreads();
                ldsp Qs = lds + ML_Q + par * 17408, Ks = lds + ML_K + par * 17408, Vs = lds + ML_V + par * 9216, Cs = lds + ML_C + par * ML_CSZ;
                LAS const float* gb = (LAS const float*)(lds + ML_GB + par * ML_GBSZ);
                const float b_end = gb[192], pm_all = gb[193];
                const float pm_t = gb[128 + t], b_t = gb[t];
                const float mx = fmaxf(pm_t, mc), ft = __expf(pm_all - mx), sc = __expf(mc - mx), em = __expf(-(b_t + mx));
                bf16x8 Qf[8];
#pragma unroll
                for (int ks = 0; ks < 8; ++ks) Qf[ks] = *(const LAS bf16x8*)(Qs + t * QRS + (16 * ks + 8 * h) * 2);
                f32x16 acc;
#pragma unroll
                for (int q = 0; q < 16; ++q) acc[q] = 0.f;
                float rstot, qn;
                f32x16 acc2;
                if (dir == 0 ? (tt == 1) : (tt == 0)) {
                    volatile LAS unsigned* fMine = (volatile LAS unsigned*)(lds + ML_XF) + 4 + 2 * tt + vt;
                    volatile LAS unsigned* fPart = (volatile LAS unsigned*)(lds + ML_XF) + 4 + 2 * tt + (vt ^ 1);
                    volatile LAS unsigned* fN = (volatile LAS unsigned*)(lds + ML_XF) + 8 + tt;
                    const int st = vt, st2 = vt ^ 1;
                    float rowsum = 0.f;
                    f32x16 s;
#pragma unroll
                    for (int q = 0; q < 16; ++q) { s[q] = 0.f; acc2[q] = 0.f; }
#pragma unroll
                    for (int ks = 0; ks < 8; ++ks) s = MFMA32(*(const LAS bf16x8*)(Ks + (32 * st + l31) * QRS + (16 * ks + 8 * h) * 2), Qf[ks], s);
#pragma unroll
                    for (int gq = 0; gq < 4; ++gq) {
                        const f32x4 av = *(LAS const f32x4*)(gb + 64 + 32 * st + 8 * gq + 4 * h);
#pragma unroll
                        for (int e = 0; e < 4; ++e) {
                            const int sidx = 32 * st + 8 * gq + 4 * h + e;
                            const bool valid = (st != tt) || (dir == 0 ? (sidx <= t) : (sidx >= t));
                            const float p = valid ? av[e] * s[4 * gq + e] : 0.f;
                            s[4 * gq + e] = p; rowsum += p;
                        }
                    }
                    const bf16x8 P0 = pack8(s[0], s[1], s[2], s[3], s[4], s[5], s[6], s[7]);
                    const bf16x8 P1 = pack8(s[8], s[9], s[10], s[11], s[12], s[13], s[14], s[15]);
                    {
                        const u32x4 w0 = __builtin_bit_cast(u32x4, P0), w1 = __builtin_bit_cast(u32x4, P1);
                        ldsp pp = XP + l31 * 144 + (32 * st + 4 * h) * 2;
                        *(LAS u32x2*)(pp) = (u32x2){w0.x, w0.y}; *(LAS u32x2*)(pp + 16) = (u32x2){w0.z, w0.w};
                        *(LAS u32x2*)(pp + 32) = (u32x2){w1.x, w1.y}; *(LAS u32x2*)(pp + 48) = (u32x2){w1.z, w1.w};
                    }
                    const float rs_own = rowsum + __shfl_xor(rowsum, 32);
                    if (h == 0) XS[64 * vt + l31] = rs_own;
                    asm volatile("s_waitcnt lgkmcnt(0)" ::: "memory");
                    if (lane == 0) *fMine = (unsigned)(i + 1);
                    {
                        ldsp vb = Vs + (32 * st + 4 * h + qsub) * VRS + (32 * vt + 16 * blk + 4 * p4) * 2;
                        acc = MFMA32(cat8(lds_tr(vb), lds_tr(vb + 8 * VRS)), P0, acc);
                        acc = MFMA32(cat8(lds_tr(vb + 16 * VRS), lds_tr(vb + 24 * VRS)), P1, acc);
                    }
#pragma unroll
                    for (int ks = 0; ks < 8; ++ks) acc2 = MFMA32(*(const LAS bf16x8*)(Cs + (32 * vt + l31) * QRS + (16 * ks + 8 * h) * 2), Qf[ks], acc2);
                    qn = 0.f;
                    if (vt == 0) {
                        f32x16 acc3;
#pragma unroll
                        for (int q = 0; q < 16; ++q) acc3[q] = 0.f;
#pragma unroll
                        for (int ks = 0; ks < 8; ++ks) acc3 = MFMA32(*(const LAS bf16x8*)(Cs + (64 + l31) * QRS + (16 * ks + 8 * h) * 2), Qf[ks], acc3);
                        if (h == 0) XS[32 + l31] = acc3[0];
                        asm volatile("s_waitcnt lgkmcnt(0)" ::: "memory");
                        if (lane == 0) *fN = (unsigned)(i + 1);
                        qn = __shfl(acc3[0], l31);
                    }
                    while (*fPart != (unsigned)(i + 1)) __builtin_amdgcn_s_sleep(1);
                    asm volatile("s_waitcnt lgkmcnt(0)" ::: "memory");
#pragma unroll
                    for (int s2 = 0; s2 < 2; ++s2) {
                        const bf16x8 Pf = *(const LAS bf16x8*)(XP + l31 * 144 + (32 * st2 + 16 * s2 + 8 * h) * 2);
                        ldsp vb2 = Vs + (32 * st2 + 16 * s2 + 8 * h + qsub) * VRS + (32 * vt + 16 * blk + 4 * p4) * 2;
                        acc = MFMA32(cat8(lds_tr(vb2), lds_tr(vb2 + 4 * VRS)), Pf, acc);
                    }
                    rstot = rs_own + XS[64 * (vt ^ 1) + l31];
                    if (vt == 1) {
                        while (*fN != (unsigned)(i + 1)) __builtin_amdgcn_s_sleep(1);
                        asm volatile("s_waitcnt lgkmcnt(0)" ::: "memory");
                        qn = XS[32 + l31];
                    }
                } else if (vt == 0) {
                    float rowsum = 0.f;
#pragma unroll
                    for (int st = 0; st < 2; ++st) {
                        if (dir == 0 ? (st > tt) : (st < tt)) continue;
                        f32x16 s;
#pragma unroll
                        for (int q = 0; q < 16; ++q) s[q] = 0.f;
#pragma unroll
                        for (int ks = 0; ks < 8; ++ks) s = MFMA32(*(const LAS bf16x8*)(Ks + (32 * st + l31) * QRS + (16 * ks + 8 * h) * 2), Qf[ks], s);
#pragma unroll
                        for (int gq = 0; gq < 4; ++gq) {
                            const f32x4 av = *(LAS const f32x4*)(gb + 64 + 32 * st + 8 * gq + 4 * h);
#pragma unroll
                            for (int e = 0; e < 4; ++e) {
                                const int sidx = 32 * st + 8 * gq + 4 * h + e;
                                const bool valid = (st != tt) || (dir == 0 ? (sidx <= t) : (sidx >= t));
                                const float p = valid ? av[e] * s[4 * gq + e] : 0.f;
                                s[4 * gq + e] = p; rowsum += p;
                            }
                        }
                        const bf16x8 P0 = pack8(s[0], s[1], s[2], s[3], s[4], s[5], s[6], s[7]);
                        const bf16x8 P1 = pack8(s[8], s[9], s[10], s[11], s[12], s[13], s[14], s[15]);
                        {
                            const u32x4 w0 = __builtin_bit_cast(u32x4, P0), w1 = __builtin_bit_cast(u32x4, P1);
                            ldsp pp = XP + l31 * 144 + (32 * st + 4 * h) * 2;
                            *(LAS u32x2*)(pp) = (u32x2){w0.x, w0.y}; *(LAS u32x2*)(pp + 16) = (u32x2){w0.z, w0.w};
                            *(LAS u32x2*)(pp + 32) = (u32x2){w1.x, w1.y}; *(LAS u32x2*)(pp + 48) = (u32x2){w1.z, w1.w};
                        }
                        ldsp vb = Vs + (32 * st + 4 * h + qsub) * VRS + (16 * blk + 4 * p4) * 2;
                        acc = MFMA32(cat8(lds_tr(vb), lds_tr(vb + 8 * VRS)), P0, acc);
                        acc = MFMA32(cat8(lds_tr(vb + 16 * VRS), lds_tr(vb + 24 * VRS)), P1, acc);
                    }
                    rstot = rowsum + __shfl_xor(rowsum, 32);
                    if (h == 0) XS[l31] = rstot;
                    asm volatile("s_waitcnt lgkmcnt(0)" ::: "memory");
                    if (lane == 0) *flagP = (unsigned)(i + 1);
                    while (*flagQ != (unsigned)(i + 1)) __builtin_amdgcn_s_sleep(1);
                    asm volatile("s_waitcnt lgkmcnt(0)" ::: "memory");
#pragma unroll
                    for (int g4 = 0; g4 < 4; ++g4) { const f32x4 x = *(LAS const f32x4*)(XQ + (g4 * 64 + lane) * 16); acc2[4 * g4] = x[0]; acc2[4 * g4 + 1] = x[1]; acc2[4 * g4 + 2] = x[2]; acc2[4 * g4 + 3] = x[3]; }
                    qn = XS[32 + l31];
                } else {
                    f32x16 accA, acc3;
#pragma unroll
                    for (int q = 0; q < 16; ++q) { accA[q] = 0.f; acc2[q] = 0.f; acc3[q] = 0.f; }
#pragma unroll
                    for (int ks = 0; ks < 8; ++ks) accA = MFMA32(*(const LAS bf16x8*)(Cs + l31 * QRS + (16 * ks + 8 * h) * 2), Qf[ks], accA);
#pragma unroll
                    for (int ks = 0; ks < 8; ++ks) acc3 = MFMA32(*(const LAS bf16x8*)(Cs + (64 + l31) * QRS + (16 * ks + 8 * h) * 2), Qf[ks], acc3);
#pragma unroll
                    for (int g4 = 0; g4 < 4; ++g4) *(LAS f32x4*)(XQ + (g4 * 64 + lane) * 16) = (f32x4){accA[4 * g4], accA[4 * g4 + 1], accA[4 * g4 + 2], accA[4 * g4 + 3]};
                    if (h == 0) XS[32 + l31] = acc3[0];
                    asm volatile("s_waitcnt lgkmcnt(0)" ::: "memory");
                    if (lane == 0) *flagQ = (unsigned)(i + 1);
#pragma unroll
                    for (int ks = 0; ks < 8; ++ks) acc2 = MFMA32(*(const LAS bf16x8*)(Cs + (32 + l31) * QRS + (16 * ks + 8 * h) * 2), Qf[ks], acc2);
                    qn = __shfl(acc3[0], l31);
                    while (*flagP != (unsigned)(i + 1)) __builtin_amdgcn_s_sleep(1);
                    asm volatile("s_waitcnt lgkmcnt(0)" ::: "memory");
#pragma unroll
                    for (int st = 0; st < 2; ++st) {
                        if (dir == 0 ? (st > tt) : (st < tt)) continue;
#pragma unroll
                        for (int s2 = 0; s2 < 2; ++s2) {
                            const bf16x8 Pf = *(const LAS bf16x8*)(XP + l31 * 144 + (32 * st + 16 * s2 + 8 * h) * 2);
                            ldsp vb2 = Vs + (32 * st + 16 * s2 + 8 * h + qsub) * VRS + (32 + 16 * blk + 4 * p4) * 2;
                            acc = MFMA32(cat8(lds_tr(vb2), lds_tr(vb2 + 4 * VRS)), Pf, acc);
                        }
                    }
                    rstot = XS[l31];
                }
#pragma unroll
                for (int q = 0; q < 16; ++q) acc[q] = ft * acc[q] + sc * acc2[q];
                const float den = ft * rstot + sc * qn;
                const float inv = 1.f / fmaxf(fabsf(den), em);
                bf16_t* hp = (Hout + (base + (size_t)chunk * 64) * 1024 + head * 256 + sl * 64) + (unsigned)(t * 1024 + 32 * vt + 4 * h);
#pragma unroll
                for (int gq = 0; gq < 4; ++gq) {
                    u32x2 w; w.x = pk2(acc[4 * gq] * inv, acc[4 * gq + 1] * inv); w.y = pk2(acc[4 * gq + 2] * inv, acc[4 * gq + 3] * inv);
                    *(u32x2*)(hp + 8 * gq) = w;
                }
                mc = b_end + fmaxf(mc, pm_all);
            }
        } else {
            const int w2 = wave - 4, tid2 = tid - 256;
            float mc = -1e30f;
            f32x16 c0, c1, nacc;
#pragma unroll
            for (int i = 0; i < 16; ++i) { c0[i] = 0.f; c1[i] = 0.f; nacc[i] = 0.f; }
            u32x4 rq0, rq1, rq2, rq3, rk0, rk1, rk2, rk3, pv0, pv1; f32x4 pg = {0.f, 0.f, 0.f, 0.f};
            ML_LOAD(dir ? NC - 1 : 0);
            ML_STORE(0);
            ML_LOAD(dir ? NC - 2 : 1);
            for (int i = 0; i < NC; ++i) {
                const int par = i & 1;
                __syncthreads();
                if (i + 1 < NC) ML_STORE(par ^ 1);
                if (i + 2 < NC) ML_LOAD(dir ? NC - 3 - i : i + 2);
                ldsp Qs = lds + ML_Q + par * 17408, Ks = lds + ML_K + par * 17408, Vs = lds + ML_V + par * 9216;
                LAS const float* gb = (LAS const float*)(lds + ML_GB + par * ML_GBSZ);
                const float b_end = gb[192], pm_all = gb[193];
                const float mxa = fmaxf(mc, pm_all), sp = __expf(mc - mxa), su = __expf(pm_all - mxa);
#pragma unroll
                for (int q = 0; q < 16; ++q) { c0[q] *= sp; c1[q] *= sp; nacc[q] *= sp; }
                const bf16x8 ONES = {(short)0x3F80, (short)0x3F80, (short)0x3F80, (short)0x3F80, (short)0x3F80, (short)0x3F80, (short)0x3F80, (short)0x3F80};
#pragma unroll
                for (int s2 = 0; s2 < 4; ++s2) {
                    ldsp kb2 = Ks + (16 * s2 + 8 * h + qsub) * QRS + (32 * w2 + 16 * blk + 4 * p4) * 2;
                    const s16x4 klo = lds_tr(kb2), khi = lds_tr(kb2 + 4 * QRS);
                    const f32x4 a0 = *(LAS const f32x4*)(gb + 64 + 16 * s2 + 8 * h), a1 = *(LAS const f32x4*)(gb + 64 + 16 * s2 + 8 * h + 4);
                    const bf16x8 Au = pack8(bf_s(klo[0]) * (a0[0] * su), bf_s(klo[1]) * (a0[1] * su), bf_s(klo[2]) * (a0[2] * su), bf_s(klo[3]) * (a0[3] * su),
                                            bf_s(khi[0]) * (a1[0] * su), bf_s(khi[1]) * (a1[1] * su), bf_s(khi[2]) * (a1[2] * su), bf_s(khi[3]) * (a1[3] * su));
                    ldsp vb2 = Vs + (16 * s2 + 8 * h + qsub) * VRS + (16 * blk + 4 * p4) * 2;
                    const bf16x8 B0 = cat8(lds_tr(vb2), lds_tr(vb2 + 4 * VRS));
                    const bf16x8 B1 = cat8(lds_tr(vb2 + 64), lds_tr(vb2 + 4 * VRS + 64));
                    c0 = MFMA32(Au, B0, c0); c1 = MFMA32(Au, B1, c1); nacc = MFMA32(Au, ONES, nacc);
                }
                {
                    ldsp Cw = lds + ML_C + (par ^ 1) * ML_CSZ;
#pragma unroll
                    for (int gq = 0; gq < 4; ++gq) {
                        const int d0 = 32 * w2 + 8 * gq + 4 * h;
                        u32x2 w; w.x = pk2(c0[4 * gq], c0[4 * gq + 1]); w.y = pk2(c0[4 * gq + 2], c0[4 * gq + 3]);
                        *(LAS u32x2*)(Cw + l31 * QRS + d0 * 2) = w;
                        w.x = pk2(c1[4 * gq], c1[4 * gq + 1]); w.y = pk2(c1[4 * gq + 2], c1[4 * gq + 3]);
                        *(LAS u32x2*)(Cw + (32 + l31) * QRS + d0 * 2) = w;
                        if (l31 == 0) { w.x = pk2(nacc[4 * gq], nacc[4 * gq + 1]); w.y = pk2(nacc[4 * gq + 2], nacc[4 * gq + 3]); *(LAS u32x2*)(Cw + 64 * QRS + d0 * 2) = w; }
                    }
                }
                mc = b_end + fmaxf(mc, pm_all);
            }
        }
#undef ML_LOAD
#undef ML_STORE
#undef ML_LD1
#undef ML_ST1
    }
    if (G >= 128 && first >= 64) {
        unsigned* cnt = (unsigned*)a.ws + 3520 + 64 * j;
        asm volatile("s_waitcnt vmcnt(0)" ::: "memory");
        __syncthreads();
        if (tid == 0) {
            __builtin_amdgcn_fence(__ATOMIC_RELEASE, "agent");
            asm volatile("s_waitcnt vmcnt(0)" ::: "memory");
            (void)__hip_atomic_fetch_add(cnt, 1u, __ATOMIC_RELAXED, __HIP_MEMORY_SCOPE_AGENT);
            unsigned sp = 0;
            while (__hip_atomic_load(cnt, __ATOMIC_RELAXED, __HIP_MEMORY_SCOPE_AGENT) < (unsigned)(G - 64)) { __builtin_amdgcn_s_sleep(2); if (++sp > (1u << 22)) break; }
            __builtin_amdgcn_fence(__ATOMIC_ACQUIRE, "agent");
            asm volatile("s_waitcnt vmcnt(0)" ::: "memory");
        }
        __syncthreads();
        hn_phase(a, j, NPROMPT, MTOK, first - 64, G - 64);
    }
}


__device__ __forceinline__ void hn_phase(const Args& a, int j, int row_lo, int row_hi, int bidx, int nblk) {
    const int tid_ = opaque_tid(); const int lane = tid_ & 63, wave = tid_ >> 6;
    const bf16_t* HF = (const bf16_t*)(a.ws + WS_R0);
    const bf16_t* HB = (const bf16_t*)(a.ws + WS_R0 + 4 * RSZ);
    const bf16_t* GG = (const bf16_t*)(a.ws + WS_R0 + 3 * RSZ);
    bf16_t* MO = (bf16_t*)(a.ws + WS_R0 + 2 * RSZ);
    const float* hn = a.in[8] + j * 1024 + 16 * lane;
    const f32x4 w0 = *(const f32x4*)(hn), w1 = *(const f32x4*)(hn + 4), w2 = *(const f32x4*)(hn + 8), w3 = *(const f32x4*)(hn + 12);
    for (int row = row_lo + bidx * 8 + wave; row < row_hi; row += nblk * 8) {
        const size_t off = (size_t)row * 1024 + 16 * lane;
        const u32x4 f0 = *(const u32x4*)(HF + off), f1 = *(const u32x4*)(HF + off + 8);
        const u32x4 b0 = *(const u32x4*)(HB + off), b1 = *(const u32x4*)(HB + off + 8);
        const u32x4 g0 = *(const u32x4*)(GG + off), g1 = *(const u32x4*)(GG + off + 8);
        float x0 = bf_lo(f0.x) + bf_lo(b0.x), x1 = bf_hi(f0.x) + bf_hi(b0.x), x2 = bf_lo(f0.y) + bf_lo(b0.y), x3 = bf_hi(f0.y) + bf_hi(b0.y);
        float x4 = bf_lo(f0.z) + bf_lo(b0.z), x5 = bf_hi(f0.z) + bf_hi(b0.z), x6 = bf_lo(f0.w) + bf_lo(b0.w), x7 = bf_hi(f0.w) + bf_hi(b0.w);
        float y0 = bf_lo(f1.x) + bf_lo(b1.x), y1 = bf_hi(f1.x) + bf_hi(b1.x), y2 = bf_lo(f1.y) + bf_lo(b1.y), y3 = bf_hi(f1.y) + bf_hi(b1.y);
        float y4 = bf_lo(f1.z) + bf_lo(b1.z), y5 = bf_hi(f1.z) + bf_hi(b1.z), y6 = bf_lo(f1.w) + bf_lo(b1.w), y7 = bf_hi(f1.w) + bf_hi(b1.w);
        float ss = x0 * x0 + x1 * x1 + x2 * x2 + x3 * x3 + x4 * x4 + x5 * x5 + x6 * x6 + x7 * x7 + y0 * y0 + y1 * y1 + y2 * y2 + y3 * y3 + y4 * y4 + y5 * y5 + y6 * y6 + y7 * y7;
        ss += __shfl_xor(ss, 1); ss += __shfl_xor(ss, 2); ss += __shfl_xor(ss, 4); ss += __shfl_xor(ss, 8);
        const float rs = rsqrtf(ss * (1.f / 256.f) + 1e-6f);
        u32x4 o0, o1;
        o0.x = pk2(x0 * rs * w0[0] * bf_lo(g0.x), x1 * rs * w0[1] * bf_hi(g0.x)); o0.y = pk2(x2 * rs * w0[2] * bf_lo(g0.y), x3 * rs * w0[3] * bf_hi(g0.y));
        o0.z = pk2(x4 * rs * w1[0] * bf_lo(g0.z), x5 * rs * w1[1] * bf_hi(g0.z)); o0.w = pk2(x6 * rs * w1[2] * bf_lo(g0.w), x7 * rs * w1[3] * bf_hi(g0.w));
        o1.x = pk2(y0 * rs * w2[0] * bf_lo(g1.x), y1 * rs * w2[1] * bf_hi(g1.x)); o1.y = pk2(y2 * rs * w2[2] * bf_lo(g1.y), y3 * rs * w2[3] * bf_hi(g1.y));
        o1.z = pk2(y4 * rs * w3[0] * bf_lo(g1.z), y5 * rs * w3[1] * bf_hi(g1.z)); o1.w = pk2(y6 * rs * w3[2] * bf_lo(g1.w), y7 * rs * w3[3] * bf_hi(g1.w));
        *(u32x4*)(MO + off) = o0; *(u32x4*)(MO + off + 8) = o1;
    }
}

#define XB_TMO      128
#define XB_XCNT(j)  (256  + 64 * (j))
#define XB_XSUB(j)  (1280 + 64 * (j))
#define XB_XGEN(j)  (2304 + 64 * (j))
#define XB_TOP      3328
#define XB_TOPGEN   3392
#define XCD_BAR_WORDS 3456
#define XB_SPIN_CAP (1u << 18)

__device__ __forceinline__ unsigned xb_ld(unsigned* p)              { return __hip_atomic_load(p, __ATOMIC_RELAXED, __HIP_MEMORY_SCOPE_AGENT); }
__device__ __forceinline__ unsigned xb_add(unsigned* p, unsigned v) { return __hip_atomic_fetch_add(p, v, __ATOMIC_RELAXED, __HIP_MEMORY_SCOPE_AGENT); }
__device__ __forceinline__ unsigned xb_xcc_id() { return (unsigned)__builtin_amdgcn_s_getreg((3 << 11) | 20) & 0xFu; }
#define XB_SPIN(cond, bar) do { unsigned _sp = 0; while (cond) { __builtin_amdgcn_s_sleep(1); \
    if ((++_sp & 255u) == 0u) { if (xb_ld(&(bar)[XB_TMO])) break; if (_sp > XB_SPIN_CAP) { atomicAdd(&(bar)[XB_TMO], 1u); break; } } } } while (0)

struct XcdBarrier {
    unsigned* bar; unsigned x;
    volatile LAS unsigned* st;
};

__device__ __forceinline__ XcdBarrier xcd_barrier_post(unsigned* bar, volatile LAS unsigned* st) {
    XcdBarrier b; b.bar = bar; b.x = xb_xcc_id(); b.st = st;
    if (threadIdx.x == 0) (void)xb_add(&bar[XB_XCNT(b.x)], 1u);
    return b;
}
__device__ __forceinline__ void xcd_barrier_complete(unsigned* bar, unsigned x, unsigned& nloc, unsigned& nx) {
    const unsigned G = gridDim.x * gridDim.y * gridDim.z;
    unsigned sum, cnt, mine, sp = 0u;
    for (;;) {
        sum = 0u; cnt = 0u; mine = 0u;
#pragma unroll
        for (unsigned j = 0; j < 16; ++j) { const unsigned c = xb_ld(&bar[XB_XCNT(j)]); sum += c; cnt += (c > 0u) ? 1u : 0u; mine = (j == x) ? c : mine; }
        if (sum == G) break;
        __builtin_amdgcn_s_sleep(1);
        if ((++sp & 255u) == 0u) { if (xb_ld(&bar[XB_TMO])) break; if (sp > XB_SPIN_CAP) { atomicAdd(&bar[XB_TMO], 1u); break; } }
    }
    nloc = mine > 0u ? mine : 1u; nx = cnt > 0u ? cnt : 1u;
}

__device__ __forceinline__ void xcd_barrier(const XcdBarrier& b) {
    asm volatile("s_waitcnt vmcnt(0)" ::: "memory");
    __syncthreads();
    if (threadIdx.x == 0) {
        unsigned* bar = b.bar;
        __builtin_amdgcn_s_waitcnt(0);
        unsigned nloc = b.st[0], nx = b.st[1];
        if (nloc == 0u) { xcd_barrier_complete(bar, b.x, nloc, nx); b.st[0] = nloc; b.st[1] = nx; }
        const unsigned old = xb_add(&bar[XB_XSUB(b.x)], 1u);
        const unsigned gen = old / nloc;
        if (old + 1u == (gen + 1u) * nloc) {
            __builtin_amdgcn_fence(__ATOMIC_RELEASE, "agent");
            asm volatile("s_waitcnt vmcnt(0)" ::: "memory");
            const unsigned og = xb_add(&bar[XB_TOP], 1u);
            const unsigned tg = og / nx;
            if (og + 1u == (tg + 1u) * nx) xb_add(&bar[XB_TOPGEN], 1u);
            else XB_SPIN(xb_ld(&bar[XB_TOPGEN]) == tg, bar);
            __builtin_amdgcn_fence(__ATOMIC_ACQUIRE, "agent");
            xb_add(&bar[XB_XGEN(b.x)], 1u);
            asm volatile("s_waitcnt vmcnt(0)" ::: "memory");
        } else {
            XB_SPIN(xb_ld(&bar[XB_XGEN(b.x)]) == gen, bar);
            __builtin_amdgcn_fence(__ATOMIC_ACQUIRE, "agent");
            asm volatile("s_waitcnt vmcnt(0)" ::: "memory");
        }
    }
    __syncthreads();
}

__global__ void __launch_bounds__(512, 2) fwd_kernel(Args a) {
    extern __shared__ __attribute__((aligned(16))) unsigned char lds_raw[];
    ldsp lds = (ldsp)lds_raw;
    cg::grid_group grid = cg::this_grid();
    const int G = gridDim.x;
    volatile LAS unsigned* bst = (volatile LAS unsigned*)(lds + LDS_BYTES - 64);
    if (threadIdx.x < 2) bst[threadIdx.x] = 0u;
    __syncthreads();
    const XcdBarrier xbar = xcd_barrier_post((unsigned*)a.ws, bst);
    for (int ph = a.ph_lo; ph < a.ph_hi; ++ph) {
        if (ph == 0) { prep_phase(a, lds, G); norm_phase(a, 0, G); }
        else if (ph == NPHASE - 1) { norm_phase(a, 2, G); }
        else {
            const int p = ph - 1, j = p >> 3, r = p & 7;
            bf16_t* R0 = (bf16_t*)(a.ws + WS_R0);
            bf16_t* R1 = (bf16_t*)(a.ws + WS_R0 + 1 * RSZ);
            bf16_t* R2 = (bf16_t*)(a.ws + WS_R0 + 2 * RSZ);
            bf16_t* R3 = (bf16_t*)(a.ws + WS_R0 + 3 * RSZ);
            bf16_t* R4 = (bf16_t*)(a.ws + WS_R0 + 4 * RSZ);
            u64_t* SS = (u64_t*)(a.ws + WS_SS);
            if (r == 0) { for (int rep = 0; rep < DUP(1); ++rep) {
                pg8::Gemm g{R0, (const bf16_t*)(a.ws + WS_WA + j * WA_SZ), MTOK, 2560, 1024};
                pg8::StaticOrder S; S.init(MTOK, 2560, G, opaque_bid());
                pg8::EpiAttnIn E{R1, R2, R2 + (size_t)MTOK * 256, R3, (const float*)(a.ws + WS_ROPE), SS + (size_t)(2 * j) * MTOK};
                pg8::gemm_phase<pg8::EpiAttnIn, pg8::StaticOrder, true, true>(lds, g, S, E); }
            } else if (r == 1) { for (int rep = 0; rep < DUP(2); ++rep) attn_phase(a, lds, j, G); }
            else if (r == 2 || r == 7) {
                const int lnext = 2 * j + (r == 2 ? 1 : 2);
                pg8::Gemm g{r == 2 ? R4 : R2, (const bf16_t*)(a.ws + (r == 2 ? WS_WAO : WS_WMO) + j * WO_SZ), MTOK, 1024, 1024};
                pg8::StaticOrder S; S.init(MTOK, 1024, G, opaque_bid());
                pg8::EpiResid E{ph == 3 ? a.in[0] : nullptr, ph == 3 ? a.in[1] : nullptr, a.out, R0, lnext < 4 ? SS + (size_t)lnext * MTOK : nullptr};
                pg8::gemm_phase<pg8::EpiResid, pg8::StaticOrder, true, true>(lds, g, S, E);
            } else if (r == 3) { for (int rep = 0; rep < DUP(5); ++rep) {
                pg8::Gemm g{R0, (const bf16_t*)(a.ws + WS_WM + j * WM_SZ), MTOK, 4352, 1024};
                pg8::StaticOrder S; S.init(MTOK, 4352, G, opaque_bid());
                pg8::EpiMlstmIn E{R1, R1 + (size_t)MTOK * 512, R2, R3, (float*)(a.ws + WS_GATES), a.in[7] + j * 16, SS + (size_t)(2 * j + 1) * MTOK};
                pg8::gemm_phase<pg8::EpiMlstmIn, pg8::StaticOrder, true, true>(lds, g, S, E); }
            } else if (r == 4) { gatescan_phase(a, G); }
            else if (r == 5) { mlstm_phase(a, lds, j, G); }
            else { if (G >= 128) hn_phase(a, j, 0, NPROMPT, opaque_bid(), G); else hn_phase(a, j, 0, MTOK, opaque_bid(), G); }
        }
        if (ph + 1 < a.ph_hi) {
            if (a.ph_hi > NPHASE) grid.sync();
            else xcd_barrier(xbar);
#ifdef DUP_SYNC
            xcd_barrier(xbar); xcd_barrier(xbar);
#endif
        }
    }
}

extern "C" void kernel_launch(void* const* d_in, const int* in_sizes, int n_in, void* d_out, int out_size, void* d_ws, size_t ws_size, hipStream_t stream) {
    static int grid = 0;
    if (grid == 0) {
        if (n_in != 11 || out_size != MTOK * DM || ws_size < WS_END) { fprintf(stderr, "kernel_launch: unexpected problem (n_in %d, out %d, ws %zu; need ws >= %zu)\n", n_in, out_size, ws_size, (size_t)WS_END); grid = -1; return; }
        int dev = 0, cus = 0, per_cu = 0;
        if (hipGetDevice(&dev) != hipSuccess || hipDeviceGetAttribute(&cus, hipDeviceAttributeMultiprocessorCount, dev) != hipSuccess) { grid = -1; return; }
        if (hipFuncSetAttribute((const void*)fwd_kernel, hipFuncAttributeMaxDynamicSharedMemorySize, LDS_BYTES) != hipSuccess) { fprintf(stderr, "kernel_launch: hipFuncSetAttribute failed\n"); grid = -1; return; }
        if (hipOccupancyMaxActiveBlocksPerMultiprocessor(&per_cu, (const void*)fwd_kernel, 512, LDS_BYTES) != hipSuccess || per_cu < 1) { fprintf(stderr, "kernel_launch: occupancy query says %d\n", per_cu); (void)hipGetLastError(); per_cu = 1; }
        grid = cus * per_cu;
    }
    if (grid < 0) return;
    if (hipMemsetAsync(d_ws, 0, 16384, stream) != hipSuccess) { fprintf(stderr, "kernel_launch: memset failed\n"); return; }
    Args a{};
    for (int i = 0; i < 11; ++i) a.in[i] = (const float*)d_in[i];
    a.out = (float*)d_out; a.ws = (unsigned char*)d_ws;
#if MK_MULTI
    for (int ph = 0; ph < NPHASE; ++ph) { a.ph_lo = ph; a.ph_hi = ph + 1; hipLaunchKernelGGL(fwd_kernel, dim3(grid), dim3(512), LDS_BYTES, stream, a); }
#else
    a.ph_lo = 0; a.ph_hi = NPHASE;
    void* args[] = {&a};
    hipError_t e = hipLaunchCooperativeKernel((void*)fwd_kernel, dim3(grid), dim3(512), args, LDS_BYTES, stream);
    if (e != hipSuccess) fprintf(stderr, "kernel_launch: cooperative launch failed: %s (grid %d)\n", hipGetErrorString(e), grid);
#endif
}
```

```cpp
#include <hip/hip_runtime.h>
#include <hip/hip_cooperative_groups.h>
#include <cstdio>
#include <cstdint>
namespace cg = cooperative_groups;
#define MK_MULTI 0
__device__ __forceinline__ int opaque_tid() { int t = threadIdx.x; asm volatile("" : "+v"(t)); return t; }
__device__ __forceinline__ int opaque_bid() { int t = blockIdx.x; asm volatile("" : "+s"(t)); return t; }
namespace pg8 {
#define PG8_LAS __attribute__((address_space(3)))
typedef unsigned short bf16_t;
typedef short bf16x8 __attribute__((ext_vector_type(8)));
typedef float f32x4 __attribute__((ext_vector_type(4)));
typedef unsigned u32x4 __attribute__((ext_vector_type(4)));
constexpr int BM = 256, BK = 64, HALF = 128, HTB = HALF * BK * 2  , STAGE_BYTES = 8 * HTB, NXCD = 8, WGM = 8;

__host__ __device__ __forceinline__ int lds_byte(int r, int c) { const int st = (r >> 4) * 2 + (c >> 5), rr = r & 15, cc = c & 31, ob = rr * 64 + cc * 2; return st * 1024 + (ob ^ (((ob >> 9) & 1) << 5)); }
__host__ __device__ __forceinline__ void stage_rc(int b, int& R, int& C) { const int st = b / 1024, sb = b % 1024, swz = sb ^ (((sb >> 9) & 1) << 5); R = (st >> 1) * 16 + swz / 64; C = (st & 1) * 32 + (swz % 64) / 2; }
__host__ __device__ __forceinline__ int perm32(int rho) { const int n = rho >> 4, i = rho & 15; return 8 * (i >> 2) + 4 * n + (i & 3); }

struct Unit { int pm, pn; };
struct Gemm { const bf16_t* A; const bf16_t* Bt; int M, N, K; };

struct StaticOrder {
    int nM, nN, nwg, G, c;
    __host__ __device__ void init(int M, int N, int G_, int c_) { nM = M / BM; nN = N / BM; nwg = nM * nN; G = G_; c = c_; }
    __host__ __device__ bool next(int i, Unit& u) const {
        const long L = (long)i * G + c; if (L >= nwg) return false;
        int wgid = (int)L; { const int q = nwg / NXCD, r = nwg % NXCD, xcd = wgid % NXCD, off = wgid / NXCD; wgid = (xcd < r ? xcd * (q + 1) : r * (q + 1) + (xcd - r) * q) + off; }
        const int nig = WGM * nN, gid = wgid / nig, fm = gid * WGM, gsz = (nM - fm) < WGM ? (nM - fm) : WGM;
        u.pm = fm + ((wgid % nig) % gsz); u.pn = (wgid % nig) / gsz; return true;
    }
    __device__ __forceinline__ void a_ready(const Unit&) const {}
    __device__ __forceinline__ void done(const Unit&) const {}
};

__device__ __forceinline__ unsigned cvt_pk_bf16(float lo, float hi) { unsigned r; asm volatile("v_cvt_pk_bf16_f32 %0, %1, %2" : "=v"(r) : "v"(lo), "v"(hi)); return r; }
typedef float f32x2 __attribute__((ext_vector_type(2)));

template <class Epi, class Sched, bool ALIGN_EPI = false, bool SP2 = false>
__device__ __forceinline__ void gemm_phase(PG8_LAS unsigned char* lds, const Gemm g, const Sched& S, const Epi& E) {
    const int tid = opaque_tid(), wid = __builtin_amdgcn_readfirstlane(tid >> 6), lane = tid & 63, wr = wid >> 2, wc = wid & 3, fr = lane & 15, fq = lane >> 4;
    const int K = g.K, nt = K / BK;
    unsigned voffA[2], voffB[2];
#pragma unroll
    for (int i = 0; i < 2; ++i) { int R, C; stage_rc(tid * 16 + i * 8192, R, C); const int Rb = Epi::PERM ? ((R & ~31) + perm32(R & 31)) : R;
        voffA[i] = (unsigned)(R * K + C) * 2u; voffB[i] = (unsigned)(Rb * K + C) * 2u; }
    const size_t kstep = (size_t)(BK * 2);
    const size_t hstep = (size_t)HALF * K * 2;
    const size_t tstep = 2 * hstep;
    const unsigned ldsw = (unsigned)wid * 1024u;
    const int aoff = lds_byte(wr * 64 + fr, fq * 8), boff = lds_byte(wc * 32 + fr, fq * 8);
#define PG8_SA(b, h) (((b) * 2 + (h)) * HTB)
#define PG8_SB(b, h) ((4 + (b) * 2 + (h)) * HTB)
#define PG8_STAGE(bufoff, gbase, voff) do { _Pragma("unroll") for (int _i = 0; _i < 2; ++_i) \
        __builtin_amdgcn_global_load_lds((const unsigned*)((const char*)(gbase) + (voff)[_i]), (PG8_LAS unsigned*)(lds + (bufoff) + ldsw + _i * 8192), 16, 0, 0); } while (0)
#define PG8_LDA(dst, b, h) do { _Pragma("unroll") for (int m = 0; m < 4; ++m) _Pragma("unroll") for (int k = 0; k < 2; ++k) dst[m][k] = *(const PG8_LAS bf16x8*)(lds + PG8_SA(b, h) + aoff + m * 2048 + k * 1024); } while (0)
#define PG8_LDB(dst, b, h) do { _Pragma("unroll") for (int n = 0; n < 2; ++n) _Pragma("unroll") for (int k = 0; k < 2; ++k) dst[n][k] = *(const PG8_LAS bf16x8*)(lds + PG8_SB(b, h) + boff + n * 2048 + k * 1024); } while (0)
#define PG8_MMA(ai, bj, At, Bt) do { __builtin_amdgcn_s_setprio(1); _Pragma("unroll") for (int m = 0; m < 4; ++m) _Pragma("unroll") for (int n = 0; n < 2; ++n) _Pragma("unroll") for (int k = 0; k < 2; ++k) \
        acc[ai][bj][m][n] = __builtin_amdgcn_mfma_f32_16x16x32_bf16(Bt[n][k], At[m][k], acc[ai][bj][m][n], 0, 0, 0); __builtin_amdgcn_s_setprio(0); } while (0)
#define PG8_WAIT_V(n) asm volatile("s_waitcnt vmcnt(" #n ")" ::: "memory")
#define PG8_WAIT_L(n) asm volatile("s_waitcnt lgkmcnt(" #n ")" ::: "memory")
#define PG8_BAR __builtin_amdgcn_s_barrier()
#define PG8_SCHED __builtin_amdgcn_sched_barrier(0)
    Unit cur, nxt; int ui = 0;
    if (!S.next(0, cur)) return;
    f32x4 acc[2][2][4][2];
#pragma unroll
    for (int a = 0; a < 2; ++a)
#pragma unroll
        for (int b = 0; b < 2; ++b)
#pragma unroll
            for (int m = 0; m < 4; ++m)
#pragma unroll
                for (int n = 0; n < 2; ++n) acc[a][b][m][n] = (f32x4){0.f, 0.f, 0.f, 0.f};
    bf16x8 At[4][2], B0[2][2], B1[2][2];
    const char* cA = (const char*)g.A + (size_t)cur.pm * tstep; const char* cB = (const char*)g.Bt + (size_t)cur.pn * tstep;
    S.a_ready(cur);
    if constexpr (SP2) {
        PG8_STAGE(PG8_SB(0, 0), cB, voffB); PG8_STAGE(PG8_SB(0, 1), cB + hstep, voffB); PG8_STAGE(PG8_SA(0, 0), cA, voffA); PG8_STAGE(PG8_SA(0, 1), cA + hstep, voffA);
        if (wr == 1) PG8_BAR;
        PG8_WAIT_V(2); PG8_BAR;
        PG8_STAGE(PG8_SB(1, 0), cB + kstep, voffB); PG8_STAGE(PG8_SA(1, 0), cA + kstep, voffA); PG8_STAGE(PG8_SB(1, 1), cB + hstep + kstep, voffB);
        PG8_WAIT_V(6); PG8_BAR;
    } else {
        PG8_STAGE(PG8_SB(0, 0), cB, voffB); PG8_STAGE(PG8_SA(0, 0), cA, voffA); PG8_STAGE(PG8_SB(0, 1), cB + hstep, voffB); PG8_STAGE(PG8_SA(0, 1), cA + hstep, voffA);
        if (wr == 1) PG8_BAR;
        PG8_WAIT_V(4); PG8_BAR;
        PG8_STAGE(PG8_SB(1, 0), cB + kstep, voffB); PG8_STAGE(PG8_SA(1, 0), cA + kstep, voffA); PG8_STAGE(PG8_SB(1, 1), cB + hstep + kstep, voffB);
        PG8_WAIT_V(6); PG8_BAR;
    }
    for (;;) {
        const bool has_next = S.next(ui + 1, nxt);
        const char* nA = has_next ? (const char*)g.A + (size_t)nxt.pm * tstep : cA; const char* nB = has_next ? (const char*)g.Bt + (size_t)nxt.pn * tstep : cB;
        for (int t = 0; t < nt; t += 2) {
            const bool last = (t == nt - 2);
            const char* a1 = cA + (size_t)(t + 1) * kstep;
            const char* a2 = last ? nA : cA + (size_t)(t + 2) * kstep; const char* b2 = last ? nB : cB + (size_t)(t + 2) * kstep;
            const char* a3 = a2 + kstep; const char* b3 = b2 + kstep;
            if (last && has_next) S.a_ready(nxt);
            if constexpr (SP2) {
            PG8_LDB(B0, 0, 0); PG8_LDB(B1, 0, 1); PG8_SCHED; PG8_LDA(At, 0, 0); PG8_STAGE(PG8_SA(1, 1), a1 + hstep, voffA);
            PG8_WAIT_V(8); PG8_WAIT_L(0); PG8_BAR; PG8_MMA(0, 0, At, B0); PG8_MMA(0, 1, At, B1); PG8_BAR; PG8_SCHED;
            PG8_LDA(At, 0, 1); PG8_STAGE(PG8_SB(0, 0), b2, voffB); PG8_STAGE(PG8_SB(0, 1), b2 + hstep, voffB); PG8_STAGE(PG8_SA(0, 0), a2, voffA);
            PG8_WAIT_V(8); PG8_WAIT_L(0); PG8_BAR; PG8_MMA(1, 0, At, B0); PG8_MMA(1, 1, At, B1); PG8_BAR; PG8_SCHED;
            PG8_LDB(B0, 1, 0); PG8_LDB(B1, 1, 1); PG8_SCHED; PG8_LDA(At, 1, 0); PG8_STAGE(PG8_SA(0, 1), a2 + hstep, voffA);
            PG8_WAIT_V(8); PG8_WAIT_L(0); PG8_BAR; PG8_MMA(0, 0, At, B0); PG8_MMA(0, 1, At, B1); PG8_BAR; PG8_SCHED;
            PG8_LDA(At, 1, 1); PG8_STAGE(PG8_SB(1, 0), b3, voffB); PG8_STAGE(PG8_SB(1, 1), b3 + hstep, voffB); PG8_STAGE(PG8_SA(1, 0), a3, voffA);
            PG8_WAIT_V(8); PG8_WAIT_L(0); PG8_BAR; PG8_MMA(1, 0, At, B0); PG8_MMA(1, 1, At, B1); PG8_BAR; PG8_SCHED;
            } else {
            PG8_LDB(B0, 0, 0); PG8_SCHED; PG8_LDA(At, 0, 0); PG8_STAGE(PG8_SA(1, 1), a1 + hstep, voffA);
            PG8_WAIT_L(8); PG8_BAR; PG8_WAIT_L(0); PG8_MMA(0, 0, At, B0); PG8_BAR; PG8_SCHED;
            PG8_LDB(B1, 0, 1); PG8_STAGE(PG8_SB(0, 0), b2, voffB);
            PG8_BAR; PG8_WAIT_L(0); PG8_MMA(0, 1, At, B1); PG8_BAR;
            PG8_LDA(At, 0, 1); PG8_STAGE(PG8_SA(0, 0), a2, voffA);
            PG8_BAR; PG8_WAIT_L(0); PG8_MMA(1, 0, At, B0); PG8_BAR; PG8_SCHED;
            PG8_STAGE(PG8_SB(0, 1), b2 + hstep, voffB);
            PG8_WAIT_V(6); PG8_BAR; PG8_MMA(1, 1, At, B1); PG8_BAR;
            PG8_LDB(B0, 1, 0); PG8_SCHED; PG8_LDA(At, 1, 0); PG8_STAGE(PG8_SA(0, 1), a2 + hstep, voffA);
            PG8_WAIT_L(8); PG8_BAR; PG8_WAIT_L(0); PG8_MMA(0, 0, At, B0); PG8_BAR; PG8_SCHED;
            PG8_LDB(B1, 1, 1); PG8_STAGE(PG8_SB(1, 0), b3, voffB);
            PG8_BAR; PG8_WAIT_L(0); PG8_MMA(0, 1, At, B1); PG8_BAR;
            PG8_LDA(At, 1, 1); PG8_STAGE(PG8_SA(1, 0), a3, voffA);
            PG8_BAR; PG8_WAIT_L(0); PG8_MMA(1, 0, At, B0); PG8_BAR; PG8_SCHED;
            PG8_STAGE(PG8_SB(1, 1), b3 + hstep, voffB);
            PG8_WAIT_V(6); PG8_BAR; PG8_MMA(1, 1, At, B1); PG8_BAR;
            }
        }
        if constexpr (ALIGN_EPI) { if (wr == 0) PG8_BAR; }
        if constexpr (!Epi::AFTER_DRAIN) { E(acc, cur, wr, wc, fr, fq); S.done(cur); }
        if (!has_next) break;
#pragma unroll
        for (int a = 0; a < 2; ++a)
#pragma unroll
            for (int b = 0; b < 2; ++b)
#pragma unroll
                for (int m = 0; m < 4; ++m)
#pragma unroll
                    for (int n = 0; n < 2; ++n) acc[a][b][m][n] = (f32x4){0.f, 0.f, 0.f, 0.f};
        cur = nxt; cA = nA; cB = nB; ++ui;
        if constexpr (ALIGN_EPI) { if (wr == 1) PG8_BAR; }
    }
    PG8_WAIT_V(0);
    if constexpr (!ALIGN_EPI) { if (wr == 0) PG8_BAR; }
    PG8_BAR;
    if constexpr (Epi::AFTER_DRAIN) { E.fused(acc, cur, wr, wc, fr, fq, lds, wid, lane); S.done(cur); }
#undef PG8_SA
#undef PG8_SB
#undef PG8_STAGE
#undef PG8_LDA
#undef PG8_LDB
#undef PG8_MMA
#undef PG8_WAIT_V
#undef PG8_WAIT_L
#undef PG8_BAR
#undef PG8_SCHED
}
}

#ifndef EN_MASK
#define EN_MASK 0xff
#endif
#define EN(x) ((EN_MASK >> (x)) & 1)
#ifndef DUP_MASK
#define DUP_MASK 0
#endif
#define DUP(x) (((DUP_MASK >> (x)) & 1) ? 2 : 1)
#ifndef MK_MULTI
#define MK_MULTI 0
#endif
#define LAS __attribute__((address_space(3)))
typedef LAS unsigned char* ldsp;
typedef unsigned short bf16_t;
typedef short bf16x8 __attribute__((ext_vector_type(8)));
typedef short s16x4 __attribute__((ext_vector_type(4)));
typedef short v4i16_t __attribute__((ext_vector_type(4)));
typedef float f32x4 __attribute__((ext_vector_type(4)));
typedef float f32x16 __attribute__((ext_vector_type(16)));
typedef unsigned u32x4 __attribute__((ext_vector_type(4)));
typedef unsigned u32x2 __attribute__((ext_vector_type(2)));
typedef __bf16 bf16x2_t __attribute__((ext_vector_type(2)));
typedef float f32x2_t __attribute__((ext_vector_type(2)));

constexpr int MTOK = 98304, DM = 1024, NPROMPT = 32768, SEQ_P = 16384, SEQ_S = 2048;
constexpr size_t MiB = 1u << 20;
constexpr size_t WS_WA = 1 * MiB, WA_SZ = 5 * MiB;
constexpr size_t WS_WAO = 11 * MiB, WO_SZ = 2 * MiB;
constexpr size_t WS_WM = 15 * MiB, WM_SZ = 4352 * 1024 * 2;
constexpr size_t WS_WMO = 32 * MiB;
constexpr size_t WS_ROPE = 36 * MiB;
constexpr size_t WS_GATES = 40 * MiB;
constexpr size_t WS_R0 = 48 * MiB, RSZ = 192 * MiB;
constexpr size_t WS_GV = WS_R0 + 5 * RSZ;
constexpr size_t WS_SS = WS_GV + 10 * MiB;
constexpr size_t WS_END = WS_SS + 3 * MiB;
constexpr float SS_SCALE = 16777216.f, SS_INV = 1.f / (16777216.f * 1024.f);
typedef unsigned long long u64_t;
constexpr int LDS_BYTES = 163840;
constexpr int NPHASE = 18;
constexpr float LOG2E = 1.4426950408889634f;

struct Args { const float* in[11]; float* out; unsigned char* ws; int ph_lo, ph_hi; };

__device__ __forceinline__ unsigned pk2(float lo, float hi) { f32x2_t v = {lo, hi}; bf16x2_t b = __builtin_convertvector(v, bf16x2_t); return __builtin_bit_cast(unsigned, b); }
__device__ __forceinline__ float bf_lo(unsigned w) { return __builtin_bit_cast(float, w << 16); }
__device__ __forceinline__ float bf_hi(unsigned w) { return __builtin_bit_cast(float, w & 0xffff0000u); }
__device__ __forceinline__ float bf_s(short s) { return __builtin_bit_cast(float, ((unsigned)(unsigned short)s) << 16); }
__device__ __forceinline__ s16x4 lds_tr(ldsp p) { return __builtin_bit_cast(s16x4, __builtin_amdgcn_ds_read_tr16_b64_v4i16((LAS v4i16_t*)p)); }
__device__ __forceinline__ bf16x8 cat8(s16x4 lo, s16x4 hi) { bf16x8 r; r[0] = lo[0]; r[1] = lo[1]; r[2] = lo[2]; r[3] = lo[3]; r[4] = hi[0]; r[5] = hi[1]; r[6] = hi[2]; r[7] = hi[3]; return r; }
__device__ __forceinline__ bf16x8 pack8(float a0, float a1, float a2, float a3, float a4, float a5, float a6, float a7) {
    u32x4 w; w.x = pk2(a0, a1); w.y = pk2(a2, a3); w.z = pk2(a4, a5); w.w = pk2(a6, a7); return __builtin_bit_cast(bf16x8, w); }
__device__ __forceinline__ float fsigmoid(float x) { return __builtin_amdgcn_rcpf(1.f + __expf(-x)); }
#define MFMA32(a, b, c) __builtin_amdgcn_mfma_f32_32x32x16_bf16((a), (b), (c), 0, 0, 0)

namespace pg8 {
struct EpiAttnIn {
    static constexpr bool PERM = true, AFTER_DRAIN = false;
    bf16_t *Q, *K, *V, *Z; const float* rope; const u64_t* ss;
    __device__ __forceinline__ void operator()(const f32x4 (&acc)[2][2][4][2], const Unit& u, int wr, int wc, int fr, int fq) const {
        const int row0 = u.pm * BM + wr * 64 + fr, pn = u.pn;
        const int colb = pn * BM + wc * 32 + 8 * fq;
        float rsv[8];
#pragma unroll
        for (int i = 0; i < 8; ++i) rsv[i] = (float)ss[row0 + (i >> 2) * HALF + (i & 3) * 16];
#pragma unroll
        for (int i = 0; i < 8; ++i) rsv[i] = rsqrtf(rsv[i] * SS_INV + 1e-6f);
        if (pn < 5) {
            f32x4 cs[2][4];
            const int cofs = ((colb & 63) >> 1) * 2;
#define ROPE_LD(i, buf) do { const int row_ = row0 + ((i) >> 2) * HALF + ((i) & 3) * 16; const int pos_ = row_ < NPROMPT ? (row_ & (SEQ_P - 1)) : (row_ & (SEQ_S - 1)); \
            const float* p_ = rope + (size_t)pos_ * 64 + cofs; cs[buf][0] = *(const f32x4*)p_; cs[buf][1] = *(const f32x4*)(p_ + 4); } while (0)
            ROPE_LD(0, 0);
#pragma unroll
            for (int i = 0; i < 8; ++i) {
                if (i + 1 < 8) ROPE_LD(i + 1, (i + 1) & 1);
                const int ai = i >> 2, mm = i & 3, row = row0 + ai * HALF + mm * 16;
                const float rs = rsv[i];
                const f32x4 c01 = cs[i & 1][0], c23 = cs[i & 1][1];
#pragma unroll
                for (int bj = 0; bj < 2; ++bj) {
                    const int col = colb + bj * HALF;
                    const f32x4 v0 = acc[ai][bj][mm][0] * rs, v1 = acc[ai][bj][mm][1] * rs;
                    f32x4 o0, o1;
                    o0[0] = v0[0] * c01[0] - v0[1] * c01[1]; o0[1] = v0[1] * c01[0] + v0[0] * c01[1];
                    o0[2] = v0[2] * c01[2] - v0[3] * c01[3]; o0[3] = v0[3] * c01[2] + v0[2] * c01[3];
                    o1[0] = v1[0] * c23[0] - v1[1] * c23[1]; o1[1] = v1[1] * c23[0] + v1[0] * c23[1];
                    o1[2] = v1[2] * c23[2] - v1[3] * c23[3]; o1[3] = v1[3] * c23[2] + v1[2] * c23[3];
                    bf16_t* dst = pn < 4 ? Q + (size_t)row * 1024 + col : K + (size_t)row * 256 + (col - 1024);
                    u32x4 w; w.x = cvt_pk_bf16(o0[0], o0[1]); w.y = cvt_pk_bf16(o0[2], o0[3]); w.z = cvt_pk_bf16(o1[0], o1[1]); w.w = cvt_pk_bf16(o1[2], o1[3]);
                    *(u32x4*)dst = w;
                }
            }
#undef ROPE_LD
        } else {
#pragma unroll
            for (int i = 0; i < 8; ++i) {
                const int ai = i >> 2, mm = i & 3, row = row0 + ai * HALF + mm * 16;
                const float rs = rsv[i];
#pragma unroll
                for (int bj = 0; bj < 2; ++bj) {
                    const int col = colb + bj * HALF;
                    f32x4 v0 = acc[ai][bj][mm][0] * rs, v1 = acc[ai][bj][mm][1] * rs;
                    bf16_t* dst;
                    if (pn == 5) dst = V + (size_t)row * 256 + (col - 1280);
                    else {
#pragma unroll
                        for (int e = 0; e < 4; ++e) { v0[e] = v0[e] * fsigmoid(v0[e]); v1[e] = v1[e] * fsigmoid(v1[e]); }
                        dst = Z + (size_t)row * 1024 + (col - 1536);
                    }
                    u32x4 w; w.x = cvt_pk_bf16(v0[0], v0[1]); w.y = cvt_pk_bf16(v0[2], v0[3]); w.z = cvt_pk_bf16(v1[0], v1[1]); w.w = cvt_pk_bf16(v1[2], v1[3]);
                    *(u32x4*)dst = w;
                }
            }
        }
    }
};
struct EpiMlstmIn {
    static constexpr bool PERM = true, AFTER_DRAIN = false;
    bf16_t *Q, *K, *V, *G; float* gates; const float* bias; const u64_t* ss;
    __device__ __forceinline__ void operator()(const f32x4 (&acc)[2][2][4][2], const Unit& u, int wr, int wc, int fr, int fq) const {
        const int row0 = u.pm * BM + wr * 64 + fr, pn = u.pn;
        float rsv[8];
#pragma unroll
        for (int i = 0; i < 8; ++i) rsv[i] = (float)ss[row0 + (i >> 2) * HALF + (i & 3) * 16];
#pragma unroll
        for (int i = 0; i < 8; ++i) rsv[i] = rsqrtf(rsv[i] * SS_INV + 1e-6f);
        f32x4 bia0 = {0.f, 0.f, 0.f, 0.f}, bia1 = {0.f, 0.f, 0.f, 0.f};
        if (pn == 16 && wc == 0 && fq < 2) { bia0 = *(const f32x4*)(bias + 8 * fq); bia1 = *(const f32x4*)(bias + 8 * fq + 4); }
#pragma unroll
        for (int ai = 0; ai < 2; ++ai)
#pragma unroll
            for (int m = 0; m < 4; ++m) {
                const int row = row0 + ai * HALF + m * 16;
                const float rs = rsv[ai * 4 + m];
#pragma unroll
                for (int bj = 0; bj < 2; ++bj) {
                    const int col = pn * BM + bj * HALF + wc * 32 + 8 * fq;
                    const f32x4 v0 = acc[ai][bj][m][0] * rs, v1 = acc[ai][bj][m][1] * rs;
                    if (pn < 8) {
                        bf16_t* dst = pn < 2 ? Q + (size_t)row * 512 + col : (pn < 4 ? K + (size_t)row * 512 + (col - 512) : V + (size_t)row * 1024 + (col - 1024));
                        u32x4 w; w.x = cvt_pk_bf16(v0[0], v0[1]); w.y = cvt_pk_bf16(v0[2], v0[3]); w.z = cvt_pk_bf16(v1[0], v1[1]); w.w = cvt_pk_bf16(v1[2], v1[3]);
                        *(u32x4*)dst = w;
                    } else if (pn < 16) {
                        const float g0 = v0[1] * __builtin_amdgcn_rcpf((1.f + __expf(-v0[0])) * (1.f + __expf(-v0[1])));
                        const float g1 = v0[3] * __builtin_amdgcn_rcpf((1.f + __expf(-v0[2])) * (1.f + __expf(-v0[3])));
                        const float g2 = v1[1] * __builtin_amdgcn_rcpf((1.f + __expf(-v1[0])) * (1.f + __expf(-v1[1])));
                        const float g3 = v1[3] * __builtin_amdgcn_rcpf((1.f + __expf(-v1[2])) * (1.f + __expf(-v1[3])));
                        u32x2 w; w.x = cvt_pk_bf16(g0, g1); w.y = cvt_pk_bf16(g2, g3);
                        *(u32x2*)(G + (size_t)row * 1024 + ((col - 2048) >> 1)) = w;
                    } else {
                        const int gc = col - 4096;
                        if (gc < 16) {
                            *(f32x4*)(gates + (size_t)row * 16 + gc) = v0 + bia0;
                            *(f32x4*)(gates + (size_t)row * 16 + gc + 4) = v1 + bia1;
                        }
                    }
                }
            }
    }
};
struct EpiResid {
    static constexpr bool PERM = true, AFTER_DRAIN = false;
    const float* in0; const float* in1;
    float* out; bf16_t* xb; u64_t* ss;
    __device__ __forceinline__ void operator()(const f32x4 (&acc)[2][2][4][2], const Unit& u, int wr, int wc, int fr, int fq) const {
        const int row0 = u.pm * BM + wr * 64 + fr;
        const size_t coff = (size_t)u.pn * BM + wc * 32 + 8 * fq;
        f32x4 pre[3][4];
#define RES_LD(i, buf) do { const int row_ = row0 + ((i) >> 2) * HALF + ((i) & 3) * 16; const size_t off_ = (size_t)row_ * 1024 + coff; \
        const float* bp_ = in0 ? (row_ < NPROMPT ? in0 + off_ : in1 + (off_ - (size_t)NPROMPT * 1024)) : out + off_; \
        pre[buf][0] = *(const f32x4*)(bp_); pre[buf][1] = *(const f32x4*)(bp_ + 4); pre[buf][2] = *(const f32x4*)(bp_ + HALF); pre[buf][3] = *(const f32x4*)(bp_ + HALF + 4); } while (0)
        RES_LD(0, 0); RES_LD(1, 1);
#pragma unroll
        for (int i = 0; i < 8; ++i) {
            if (i + 2 < 8) RES_LD(i + 2, (i + 2) % 3);
            const int ai = i >> 2, mm = i & 3, row = row0 + ai * HALF + mm * 16;
            const size_t off = (size_t)row * 1024 + coff;
            float sq = 0.f;
#pragma unroll
            for (int bj = 0; bj < 2; ++bj) {
                const f32x4 x0 = pre[i % 3][2 * bj] + acc[ai][bj][mm][0], x1 = pre[i % 3][2 * bj + 1] + acc[ai][bj][mm][1];
                *(f32x4*)(out + off + bj * HALF) = x0; *(f32x4*)(out + off + bj * HALF + 4) = x1;
                if (ss) {
                    u32x4 w; w.x = cvt_pk_bf16(x0[0], x0[1]); w.y = cvt_pk_bf16(x0[2], x0[3]); w.z = cvt_pk_bf16(x1[0], x1[1]); w.w = cvt_pk_bf16(x1[2], x1[3]);
                    *(u32x4*)(xb + off + bj * HALF) = w;
                    sq += x0[0] * x0[0] + x0[1] * x0[1] + x0[2] * x0[2] + x0[3] * x0[3] + x1[0] * x1[0] + x1[1] * x1[1] + x1[2] * x1[2] + x1[3] * x1[3];
                }
            }
            if (ss) {
                sq += __shfl_xor(sq, 16); sq += __shfl_xor(sq, 32);
                if (fq == 0) atomicAdd(ss + row, (u64_t)(sq * SS_SCALE + 0.5f));
            }
        }
#undef RES_LD
    }
};
}

__device__ __forceinline__ void prep_phase(const Args& a, ldsp lds, int G) {
    const int tid = opaque_tid();
    LAS float* tile = (LAS float*)lds;
    for (int it = opaque_bid(); it < 4480; it += G) {
        const int j = it / 2240; int r = it % 2240; int wt;
        if (r < 640) wt = 0; else if (r < 896) { wt = 1; r -= 640; } else if (r < 1984) { wt = 2; r -= 896; } else { wt = 3; r -= 1984; }
        const int nt = r >> 4, kt = r & 15;
        const float* W; int Nsrc; const float* g = nullptr; bf16_t* dst;
        if (wt == 0) { W = a.in[3] + (size_t)j * 1024 * 2560; Nsrc = 2560; g = a.in[2] + (2 * j) * 1024; dst = (bf16_t*)(a.ws + WS_WA + j * WA_SZ); }
        else if (wt == 1) { W = a.in[5] + (size_t)j * 1024 * 1024; Nsrc = 1024; dst = (bf16_t*)(a.ws + WS_WAO + j * WO_SZ); }
        else if (wt == 2) { W = a.in[6] + (size_t)j * 1024 * 4112; Nsrc = 4112; g = a.in[2] + (2 * j + 1) * 1024; dst = (bf16_t*)(a.ws + WS_WM + j * WM_SZ); }
        else { W = a.in[9] + (size_t)j * 1024 * 1024; Nsrc = 1024; dst = (bf16_t*)(a.ws + WS_WMO + j * WO_SZ); }
        const int nn = tid & 63, np = nt * 64 + nn;
        int src = np; float sc = 1.f;
        if (wt == 0) {
            if (np < 1280) { const int base = np < 1024 ? 0 : 1024, m = np - base; src = base + (m & ~63) + ((m & 63) >> 1) + 32 * (m & 1); if (np < 1024) sc = 0.125f * LOG2E; }
        } else if (wt == 2) {
            if (np < 2048) { if (np >= 512 && np < 1024) sc = 0.08838834764831845f; }
            else if (np < 4096) { const int jj = np - 2048; src = (jj & 1) ? 3072 + (jj >> 1) : 2048 + (jj >> 1); }
            else if (np >= 4112) src = -1;
        }
#pragma unroll
        for (int p = 0; p < 8; ++p) {
            const int kk = p * 8 + (tid >> 6), k = kt * 64 + kk; float v = 0.f;
            if (src >= 0) { v = W[(size_t)k * Nsrc + src] * sc; if (g) v *= g[k]; }
            tile[kk * 65 + nn] = v;
        }
        __syncthreads();
        {
            const int n2 = tid >> 3, kc = tid & 7;
            const float v0 = tile[(kc * 8 + 0) * 65 + n2], v1 = tile[(kc * 8 + 1) * 65 + n2], v2 = tile[(kc * 8 + 2) * 65 + n2], v3 = tile[(kc * 8 + 3) * 65 + n2];
            const float v4 = tile[(kc * 8 + 4) * 65 + n2], v5 = tile[(kc * 8 + 5) * 65 + n2], v6 = tile[(kc * 8 + 6) * 65 + n2], v7 = tile[(kc * 8 + 7) * 65 + n2];
            u32x4 w; w.x = pk2(v0, v1); w.y = pk2(v2, v3); w.z = pk2(v4, v5); w.w = pk2(v6, v7);
            *(u32x4*)(dst + (size_t)(nt * 64 + n2) * 1024 + kt * 64 + kc * 8) = w;
        }
        __syncthreads();
    }
    float* rope = (float*)(a.ws + WS_ROPE);
    for (int idx = opaque_bid() * 512 + tid; idx < 16384 * 32; idx += G * 512) {
        const int pos = idx >> 5, i = idx & 31;
        const float inv = expf((-9.210340371976184f * (float)i) / 32.0f);
        const float ang = (float)pos * inv;
        double rev = (double)ang * 0.15915494309189535; rev -= floor(rev);
        const float fr = (float)rev;
        rope[2 * idx] = __builtin_amdgcn_cosf(fr); rope[2 * idx + 1] = __builtin_amdgcn_sinf(fr);
    }
}

__device__ __forceinline__ void norm_phase(const Args& a, int mode, int G) {
    const int tid_ = opaque_tid(); const int lane = tid_ & 63, wave = tid_ >> 6;
    bf16_t* xb = (bf16_t*)(a.ws + WS_R0);
    u64_t* ss0 = (u64_t*)(a.ws + WS_SS);
    if (mode == 0) { for (int i = opaque_bid() * 512 + tid_; i < 3 * MTOK; i += G * 512) ss0[MTOK + i] = 0ull; }
    for (int row = opaque_bid() * 8 + wave; row < MTOK; row += G * 8) {
        const float* src = mode == 0 ? (row < NPROMPT ? a.in[0] + (size_t)row * DM : a.in[1] + (size_t)(row - NPROMPT) * DM) : a.out + (size_t)row * DM;
        const f32x4 v0 = __builtin_nontemporal_load((const f32x4*)src + lane), v1 = __builtin_nontemporal_load((const f32x4*)src + lane + 64), v2 = __builtin_nontemporal_load((const f32x4*)src + lane + 128), v3 = __builtin_nontemporal_load((const f32x4*)src + lane + 192);
        float ss = v0[0] * v0[0] + v0[1] * v0[1] + v0[2] * v0[2] + v0[3] * v0[3] + v1[0] * v1[0] + v1[1] * v1[1] + v1[2] * v1[2] + v1[3] * v1[3]
                 + v2[0] * v2[0] + v2[1] * v2[1] + v2[2] * v2[2] + v2[3] * v2[3] + v3[0] * v3[0] + v3[1] * v3[1] + v3[2] * v3[2] + v3[3] * v3[3];
#pragma unroll
        for (int o = 32; o >= 1; o >>= 1) ss += __shfl_xor(ss, o);
        if (mode == 2) {
            const float rs = rsqrtf(ss * (1.f / 1024.f) + 1e-6f);
            const f32x4* g = (const f32x4*)a.in[10];
            f32x4* o = (f32x4*)(a.out + (size_t)row * DM);
            __builtin_nontemporal_store(v0 * rs * g[lane], o + lane); __builtin_nontemporal_store(v1 * rs * g[lane + 64], o + lane + 64); __builtin_nontemporal_store(v2 * rs * g[lane + 128], o + lane + 128); __builtin_nontemporal_store(v3 * rs * g[lane + 192], o + lane + 192);
        } else {
            u32x2* o = (u32x2*)(xb + (size_t)row * DM);
            u32x2 w;
            w.x = pk2(v0[0], v0[1]); w.y = pk2(v0[2], v0[3]); o[lane] = w;
            w.x = pk2(v1[0], v1[1]); w.y = pk2(v1[2], v1[3]); o[lane + 64] = w;
            w.x = pk2(v2[0], v2[1]); w.y = pk2(v2[2], v2[3]); o[lane + 128] = w;
            w.x = pk2(v3[0], v3[1]); w.y = pk2(v3[2], v3[3]); o[lane + 192] = w;
            if (lane == 0) ss0[row] = (u64_t)(ss * SS_SCALE + 0.5f);
        }
    }
}

constexpr int KRS = 144;
__device__ __forceinline__ void attn_phase(const Args& a, ldsp lds, int j, int G) {
    const int tid = opaque_tid(), lane = tid & 63, wave = tid >> 6, l31 = lane & 31, h = lane >> 5;
    const int blk = (lane >> 4) & 1, qsub = (lane & 15) >> 2, p4 = lane & 3;
    const bf16_t* Q = (const bf16_t*)(a.ws + WS_R0 + 1 * RSZ);
    const bf16_t* K = (const bf16_t*)(a.ws + WS_R0 + 2 * RSZ);
    const bf16_t* V = (const bf16_t*)(a.ws + WS_R0 + 2 * RSZ + 48 * MiB);
    const bf16_t* Z = (const bf16_t*)(a.ws + WS_R0 + 3 * RSZ);
    bf16_t* O = (bf16_t*)(a.ws + WS_R0 + 4 * RSZ);
    const float* sink = a.in[4] + j * 16;
    ldsp Ks = lds, Vs = lds + 384 * KRS;
    for (int u = opaque_bid(); u < 3072; u += G) {
        const int g = u & 3, qb = u >> 2, q0 = qb * 128;
        int ss, se;
        if (q0 < NPROMPT) { ss = q0 & ~(SEQ_P - 1); se = ss + SEQ_P; } else { ss = q0 & ~(SEQ_S - 1); se = ss + SEQ_S; }
        const int r = wave >> 1, qtA = 2 * (wave & 1), head = 4 * g + r, r0 = q0 + 32 * qtA;
        const bf16_t* qpa = Q + (size_t)(r0 + l31) * 1024 + head * 64 + 8 * h;
        const bf16_t* qpb = qpa + 32 * 1024;
        const bf16x8 QA0 = *(const bf16x8*)(qpa), QA1 = *(const bf16x8*)(qpa + 16), QA2 = *(const bf16x8*)(qpa + 32), QA3 = *(const bf16x8*)(qpa + 48);
        const bf16x8 QB0 = *(const bf16x8*)(qpb), QB1 = *(const bf16x8*)(qpb + 16), QB2 = *(const bf16x8*)(qpb + 32), QB3 = *(const bf16x8*)(qpb + 48);
        __syncthreads();
#pragma unroll
        for (int i = 0; i < 6; ++i) {
            const int c = tid + 512 * i, r = c >> 3, ch = c & 7, grow = q0 - 128 + r;
            u32x4 kv = {0u, 0u, 0u, 0u}, vv = {0u, 0u, 0u, 0u};
            if (grow >= ss && grow < se) { kv = *(const u32x4*)(K + (size_t)grow * 256 + g * 64 + ch * 8); vv = *(const u32x4*)(V + (size_t)grow * 256 + g * 64 + ch * 8); }
            *(LAS u32x4*)(Ks + r * KRS + ch * 16) = kv; *(LAS u32x4*)(Vs + r * KRS + ch * 16) = vv;
        }
        __syncthreads();
        {
            const float m0 = sink[head] * LOG2E;
            float mA = m0, mB = m0, lA = h == 0 ? 1.f : 0.f, lB = lA;
            f32x16 OA0, OA1, OB0, OB1;
#pragma unroll
            for (int i = 0; i < 16; ++i) { OA0[i] = 0.f; OA1[i] = 0.f; OB0[i] = 0.f; OB1[i] = 0.f; }
            for (int kt = 0; kt < 10; ++kt) {
                const int kb = 32 * qtA + 32 * kt, kg = q0 - 128 + kb;
                if (kg < ss || kg >= se) continue;
                ldsp kp = Ks + (kb + l31) * KRS + 16 * h;
                const bf16x8 K0 = *(const LAS bf16x8*)(kp), K1 = *(const LAS bf16x8*)(kp + 32), K2 = *(const LAS bf16x8*)(kp + 64), K3 = *(const LAS bf16x8*)(kp + 96);
                ldsp vb = Vs + (kb + 4 * h + qsub) * KRS + (16 * blk + 4 * p4) * 2;
                const bf16x8 V00 = cat8(lds_tr(vb), lds_tr(vb + 8 * KRS)), V01 = cat8(lds_tr(vb + 64), lds_tr(vb + 8 * KRS + 64));
                const bf16x8 V10 = cat8(lds_tr(vb + 16 * KRS), lds_tr(vb + 24 * KRS)), V11 = cat8(lds_tr(vb + 16 * KRS + 64), lds_tr(vb + 24 * KRS + 64));
#define ATT_JOB(QQ0, QQ1, QQ2, QQ3, MM, LL, OO0, OO1, KTJ) do { \
                    f32x16 s; \
                    _Pragma("unroll") for (int i = 0; i < 16; ++i) s[i] = 0.f; \
                    s = MFMA32(K0, QQ0, s); s = MFMA32(K1, QQ1, s); s = MFMA32(K2, QQ2, s); s = MFMA32(K3, QQ3, s); \
                    if ((KTJ) == 0 || (KTJ) == 8) { \
                        _Pragma("unroll") for (int i = 0; i < 16; ++i) { const int kk = (i & 3) + 8 * (i >> 2) + 4 * h; \
                            const bool valid = (KTJ) == 0 ? (kk >= l31) : (kk <= l31); if (!valid) s[i] = -INFINITY; } } \
                    float mx = s[0]; \
                    _Pragma("unroll") for (int i = 1; i < 16; ++i) mx = fmaxf(mx, s[i]); \
                    mx = fmaxf(mx, __shfl_xor(mx, 32)); \
                    if (__any(mx > MM + 8.f)) {            \
                        const float mn = fmaxf(MM, mx), alpha = __builtin_amdgcn_exp2f(MM - mn); MM = mn; LL *= alpha; \
                        _Pragma("unroll") for (int i = 0; i < 16; ++i) { OO0[i] *= alpha; OO1[i] *= alpha; } } \
                    float ps = 0.f; \
                    _Pragma("unroll") for (int i = 0; i < 16; ++i) { s[i] = __builtin_amdgcn_exp2f(s[i] - MM); ps += s[i]; } \
                    LL += ps; \
                    const bf16x8 P0 = pack8(s[0], s[1], s[2], s[3], s[4], s[5], s[6], s[7]); \
                    const bf16x8 P1 = pack8(s[8], s[9], s[10], s[11], s[12], s[13], s[14], s[15]); \
                    OO0 = MFMA32(V00, P0, OO0); OO1 = MFMA32(V01, P0, OO1); OO0 = MFMA32(V10, P1, OO0); OO1 = MFMA32(V11, P1, OO1); } while (0)
                if (kt < 9) ATT_JOB(QA0, QA1, QA2, QA3, mA, lA, OA0, OA1, kt);
                if (kt > 0) ATT_JOB(QB0, QB1, QB2, QB3, mB, lB, OB0, OB1, kt - 1);
#undef ATT_JOB
            }
#define ATT_OUT(LL, OO0, OO1, ROWOFF) do { \
                LL += __shfl_xor(LL, 32); \
                const float inv = 1.f / LL; \
                const size_t orow = (size_t)(r0 + (ROWOFF) + l31) * 1024 + head * 64; \
                _Pragma("unroll") for (int gq = 0; gq < 4; ++gq) { \
                    const int d0 = 8 * gq + 4 * h; \
                    const u32x2 z0 = *(const u32x2*)(Z + orow + d0), z1 = *(const u32x2*)(Z + orow + 32 + d0); \
                    u32x2 w; \
                    w.x = pk2(OO0[4 * gq] * inv * bf_lo(z0.x), OO0[4 * gq + 1] * inv * bf_hi(z0.x)); w.y = pk2(OO0[4 * gq + 2] * inv * bf_lo(z0.y), OO0[4 * gq + 3] * inv * bf_hi(z0.y)); \
                    *(u32x2*)(O + orow + d0) = w; \
                    w.x = pk2(OO1[4 * gq] * inv * bf_lo(z1.x), OO1[4 * gq + 1] * inv * bf_hi(z1.x)); w.y = pk2(OO1[4 * gq + 2] * inv * bf_lo(z1.y), OO1[4 * gq + 3] * inv * bf_hi(z1.y)); \
                    *(u32x2*)(O + orow + 32 + d0) = w; } } while (0)
            ATT_OUT(lA, OA0, OA1, 0);
            ATT_OUT(lB, OB0, OB1, 32);
#undef ATT_OUT
        }
    }
}

constexpr int GV_STRIDE = 208;
__device__ __forceinline__ void gatescan_phase(const Args& a, int G) {
    const int tid_ = opaque_tid(); const int lane = tid_ & 63, wave = tid_ >> 6;
    const float* gates = (const float*)(a.ws + WS_GATES);
    float* GV = (float*)(a.ws + WS_GV);
    for (int task = opaque_bid() * 8 + wave; task < 1536 * 8; task += G * 8) {
        const int cgl = task >> 3, dh = task & 7, dir = dh >> 2, head = dh & 3;
        const int jx = dir ? 63 - lane : lane;
        const float* gp = gates + ((size_t)cgl * 64 + jx) * 16 + dir * 8 + head;
        const float gi = gp[0], gf = gp[4];
        float x = fminf(gf, 0.f) - log1pf(expf(-fabsf(gf)));
#pragma unroll
        for (int d = 1; d < 64; d <<= 1) { const float t = __shfl_up(x, d); if (lane >= d) x += t; }
        const float aa = gi - x; float pmx = aa;
#pragma unroll
        for (int d = 1; d < 64; d <<= 1) { const float t = __shfl_up(pmx, d); if (lane >= d) pmx = fmaxf(pmx, t); }
        float* o = GV + (size_t)task * GV_STRIDE;
        const float pm_all = __shfl(pmx, 63);
        o[jx] = x; o[64 + jx] = __expf(aa - pm_all); o[128 + jx] = pmx;
        if (lane == 63) { o[192] = x; o[193] = pmx; }
    }
}

constexpr int QRS = 272, VRS = 144;
constexpr int ML_XB = 141952, ML_XP = ML_XB, ML_XQ = ML_XB + 9216, ML_XS = ML_XQ + 8192, ML_XF = ML_XS + 1024;
constexpr int ML_Q = 0, ML_K = 34816, ML_V = 69632, ML_C = 88064, ML_CSZ = 26112  , ML_GB = 140288, ML_GBSZ = 832;
__device__ __forceinline__ void hn_phase(const Args& a, int j, int row_lo, int row_hi, int bidx, int nblk);
__device__ __forceinline__ void mlstm_phase(const Args& a, ldsp lds, int j, int G) {
    const int tid = opaque_tid(), lane = tid & 63, wave = __builtin_amdgcn_readfirstlane(tid >> 6), l31 = lane & 31, h = lane >> 5;
    const int blk = (lane >> 4) & 1, qsub = (lane & 15) >> 2, p4 = lane & 3;
    const bf16_t* Qg = (const bf16_t*)(a.ws + WS_R0 + 1 * RSZ);
    const bf16_t* Kg = (const bf16_t*)(a.ws + WS_R0 + 1 * RSZ + 96 * MiB);
    const bf16_t* Vg = (const bf16_t*)(a.ws + WS_R0 + 2 * RSZ);
    const float* GV = (const float*)(a.ws + WS_GV);
    int first, stride;
    if (G >= 128) {
        first = opaque_bid(); stride = first < 64 ? (1 << 28) : G - 64;
        if (first >= 64 && ((G - 64) & 31) == 0) { const int xcd = first & 7, idx = (first - 64) >> 3, per = (G - 64) >> 3; first = 64 + xcd * per + idx; }
    } else { first = opaque_bid(); stride = G; }
#define ML_LD1(k, dq, dk) do { const unsigned o_ = (unsigned)(((tid2 + 256 * (k)) >> 4) * 512 + ((tid2 + 256 * (k)) & 15) * 8); dq = *(const u32x4*)(qu_ + o_); dk = *(const u32x4*)(ku_ + o_); } while (0)
#define ML_ST1(k, dq, dk) do { const int c = tid2 + 256 * (k), r = c >> 4, ch = c & 15; *(LAS u32x4*)(Qw + r * QRS + ch * 16) = dq; *(LAS u32x4*)(Kw + r * QRS + ch * 16) = dk; } while (0)
#define ML_LOAD(chunk) do { const size_t tok0 = base + (size_t)(chunk) * 64;     \
            const bf16_t* qu_ = Qg + tok0 * 512 + head * 128; const bf16_t* ku_ = Kg + tok0 * 512 + head * 128; const bf16_t* vu_ = Vg + tok0 * 1024 + head * 256 + sl * 64; \
            ML_LD1(0, rq0, rk0); ML_LD1(1, rq1, rk1); ML_LD1(2, rq2, rk2); ML_LD1(3, rq3, rk3); \
            { const unsigned o_ = (unsigned)((tid2 >> 3) * 1024 + (tid2 & 7) * 8); pv0 = *(const u32x4*)(vu_ + o_); pv1 = *(const u32x4*)(vu_ + (o_ + 32u * 1024u)); } \
            if (tid2 < 52) pg = *(const f32x4*)(gvb + (size_t)(chunk) * (8 * GV_STRIDE) + (unsigned)(tid2 * 4)); } while (0)
#define ML_STORE(par) do { ldsp Qw = lds + ML_Q + (par) * 17408, Kw = lds + ML_K + (par) * 17408, Vw = lds + ML_V + (par) * 9216; \
            ML_ST1(0, rq0, rk0); ML_ST1(1, rq1, rk1); ML_ST1(2, rq2, rk2); ML_ST1(3, rq3, rk3); \
            { const int r = tid2 >> 3, ch = tid2 & 7; *(LAS u32x4*)(Vw + r * VRS + ch * 16) = pv0; *(LAS u32x4*)(Vw + (32 + r) * VRS + ch * 16) = pv1; } \
            if (tid2 < 52) *(LAS f32x4*)(lds + ML_GB + (par) * ML_GBSZ + tid2 * 16) = pg; } while (0)
    for (int it = first; it < 1088; it += stride) {
        int seq, NC; size_t base; int t2 = it;
        if (it < 64) { NC = 256; seq = it >> 5; base = (size_t)seq * SEQ_P; } else { t2 = it - 64; NC = 32; seq = t2 >> 5; base = (size_t)NPROMPT + (size_t)seq * SEQ_S; }
        const int head = (t2 >> 3) & 3, dir = (t2 >> 2) & 1, sl = t2 & 3;
        bf16_t* Hout = (bf16_t*)(a.ws + WS_R0 + (dir ? 4 * RSZ : 0));
        __syncthreads();
        for (int i = tid; i < 2 * ML_CSZ / 16; i += 512) *(LAS u32x4*)(lds + ML_C + i * 16) = (u32x4){0u, 0u, 0u, 0u};
        if (tid < 16) ((LAS unsigned*)(lds + ML_XF))[tid] = 0u;
        const float* gvb = GV + ((base >> 6) * 8 + dir * 4 + head) * GV_STRIDE;
        if (wave < 4) {
            const int vt = wave & 1, tt = wave >> 1, t = 32 * tt + l31;
            float mc = -1e30f;
            ldsp XP = lds + ML_XP + tt * 4608, XQ = lds + ML_XQ + tt * 4096;
            LAS float* XS = (LAS float*)(lds + ML_XS + tt * 512);
            volatile LAS unsigned* flagP = (volatile LAS unsigned*)(lds + ML_XF) + tt;
            volatile LAS unsigned* flagQ = (volatile LAS unsigned*)(lds + ML_XF) + 2 + tt;
            for (int i = 0; i < NC; ++i) {
                const int chunk = dir ? NC - 1 - i : i, par = i & 1;
                __syncthreads();
                ldsp Qs = lds + ML_Q + par * 17408, Ks = lds + ML_K + par * 17408, Vs = lds + ML_V + par * 9216, Cs = lds + ML_C + par * ML_CSZ;
                LAS const float* gb = (LAS const float*)(lds + ML_GB + par * ML_GBSZ);
                const float b_end = gb[192], pm_all = gb[193];
                const float pm_t = gb[128 + t], b_t = gb[t];
                const float mx = fmaxf(pm_t, mc), ft = __expf(pm_all - mx), sc = __expf(mc - mx), em = __expf(-(b_t + mx));
                bf16x8 Qf[8];
#pragma unroll
                for (int ks = 0; ks < 8; ++ks) Qf[ks] = *(const LAS bf16x8*)(Qs + t * QRS + (16 * ks + 8 * h) * 2);
                f32x16 acc;
#pragma unroll
                for (int q = 0; q < 16; ++q) acc[q] = 0.f;
                float rstot, qn;
                f32x16 acc2;
                if (dir == 0 ? (tt == 1) : (tt == 0)) {
                    volatile LAS unsigned* fMine = (volatile LAS unsigned*)(lds + ML_XF) + 4 + 2 * tt + vt;
                    volatile LAS unsigned* fPart = (volatile LAS unsigned*)(lds + ML_XF) + 4 + 2 * tt + (vt ^ 1);
                    volatile LAS unsigned* fN = (volatile LAS unsigned*)(lds + ML_XF) + 8 + tt;
                    const int st = vt, st2 = vt ^ 1;
                    float rowsum = 0.f;
                    f32x16 s;
#pragma unroll
                    for (int q = 0; q < 16; ++q) { s[q] = 0.f; acc2[q] = 0.f; }
#pragma unroll
                    for (int ks = 0; ks < 8; ++ks) s = MFMA32(*(const LAS bf16x8*)(Ks + (32 * st + l31) * QRS + (16 * ks + 8 * h) * 2), Qf[ks], s);
#pragma unroll
                    for (int gq = 0; gq < 4; ++gq) {
                        const f32x4 av = *(LAS const f32x4*)(gb + 64 + 32 * st + 8 * gq + 4 * h);
#pragma unroll
                        for (int e = 0; e < 4; ++e) {
                            const int sidx = 32 * st + 8 * gq + 4 * h + e;
                            const bool valid = (st != tt) || (dir == 0 ? (sidx <= t) : (sidx >= t));
                            const float p = valid ? av[e] * s[4 * gq + e] : 0.f;
                            s[4 * gq + e] = p; rowsum += p;
                        }
                    }
                    const bf16x8 P0 = pack8(s[0], s[1], s[2], s[3], s[4], s[5], s[6], s[7]);
                    const bf16x8 P1 = pack8(s[8], s[9], s[10], s[11], s[12], s[13], s[14], s[15]);
                    {
                        const u32x4 w0 = __builtin_bit_cast(u32x4, P0), w1 = __builtin_bit_cast(u32x4, P1);
                        ldsp pp = XP + l31 * 144 + (32 * st + 4 * h) * 2;
                        *(LAS u32x2*)(pp) = (u32x2){w0.x, w0.y}; *(LAS u32x2*)(pp + 16) = (u32x2){w0.z, w0.w};
                        *(LAS u32x2*)(pp + 32) = (u32x2){w1.x, w1.y}; *(LAS u32x2*)(pp + 48) = (u32x2){w1.z, w1.w};
                    }
                    const float rs_own = rowsum + __shfl_xor(rowsum, 32);
                    if (h == 0) XS[64 * vt + l31] = rs_own;
                    asm volatile("s_waitcnt lgkmcnt(0)" ::: "memory");
                    if (lane == 0) *fMine = (unsigned)(i + 1);
                    {
                        ldsp vb = Vs + (32 * st + 4 * h + qsub) * VRS + (32 * vt + 16 * blk + 4 * p4) * 2;
                        acc = MFMA32(cat8(lds_tr(vb), lds_tr(vb + 8 * VRS)), P0, acc);
                        acc = MFMA32(cat8(lds_tr(vb + 16 * VRS), lds_tr(vb + 24 * VRS)), P1, acc);
                    }
#pragma unroll
                    for (int ks = 0; ks < 8; ++ks) acc2 = MFMA32(*(const LAS bf16x8*)(Cs + (32 * vt + l31) * QRS + (16 * ks + 8 * h) * 2), Qf[ks], acc2);
                    qn = 0.f;
                    if (vt == 0) {
                        f32x16 acc3;
#pragma unroll
                        for (int q = 0; q < 16; ++q) acc3[q] = 0.f;
#pragma unroll
                        for (int ks = 0; ks < 8; ++ks) acc3 = MFMA32(*(const LAS bf16x8*)(Cs + (64 + l31) * QRS + (16 * ks + 8 * h) * 2), Qf[ks], acc3);
                        if (h == 0) XS[32 + l31] = acc3[0];
                        asm volatile("s_waitcnt lgkmcnt(0)" ::: "memory");
                        if (lane == 0) *fN = (unsigned)(i + 1);
                        qn = __shfl(acc3[0], l31);
                    }
                    while (*fPart != (unsigned)(i + 1)) __builtin_amdgcn_s_sleep(1);
                    asm volatile("s_waitcnt lgkmcnt(0)" ::: "memory");
#pragma unroll
                    for (int s2 = 0; s2 < 2; ++s2) {
                        const bf16x8 Pf = *(const LAS bf16x8*)(XP + l31 * 144 + (32 * st2 + 16 * s2 + 8 * h) * 2);
                        ldsp vb2 = Vs + (32 * st2 + 16 * s2 + 8 * h + qsub) * VRS + (32 * vt + 16 * blk + 4 * p4) * 2;
                        acc = MFMA32(cat8(lds_tr(vb2), lds_tr(vb2 + 4 * VRS)), Pf, acc);
                    }
                    rstot = rs_own + XS[64 * (vt ^ 1) + l31];
                    if (vt == 1) {
                        while (*fN != (unsigned)(i + 1)) __builtin_amdgcn_s_sleep(1);
                        asm volatile("s_waitcnt lgkmcnt(0)" ::: "memory");
                        qn = XS[32 + l31];
                    }
                } else if (vt == 0) {
                    float rowsum = 0.f;
#pragma unroll
                    for (int st = 0; st < 2; ++st) {
                        if (dir == 0 ? (st > tt) : (st < tt)) continue;
                        f32x16 s;
#pragma unroll
                        for (int q = 0; q < 16; ++q) s[q] = 0.f;
#pragma unroll
                        for (int ks = 0; ks < 8; ++ks) s = MFMA32(*(const LAS bf16x8*)(Ks + (32 * st + l31) * QRS + (16 * ks + 8 * h) * 2), Qf[ks], s);
#pragma unroll
                        for (int gq = 0; gq < 4; ++gq) {
                            const f32x4 av = *(LAS const f32x4*)(gb + 64 + 32 * st + 8 * gq + 4 * h);
#pragma unroll
                            for (int e = 0; e < 4; ++e) {
                                const int sidx = 32 * st + 8 * gq + 4 * h + e;
                                const bool valid = (st != tt) || (dir == 0 ? (sidx <= t) : (sidx >= t));
                                const float p = valid ? av[e] * s[4 * gq + e] : 0.f;
                                s[4 * gq + e] = p; rowsum += p;
                            }
                        }
                        const bf16x8 P0 = pack8(s[0], s[1], s[2], s[3], s[4], s[5], s[6], s[7]);
                        const bf16x8 P1 = pack8(s[8], s[9], s[10], s[11], s[12], s[13], s[14], s[15]);
                        {
                            const u32x4 w0 = __builtin_bit_cast(u32x4, P0), w1 = __builtin_bit_cast(u32x4, P1);
                            ldsp pp = XP + l31 * 144 + (32 * st + 4 * h) * 2;
                            *(LAS u32x2*)(pp) = (u32x2){w0.x, w0.y}; *(LAS u32x2*)(pp + 16) = (u32x2){w0.z, w0.w};
                            *(LAS u32x2*)(pp + 32) = (u32x2){w1.x, w1.y}; *(LAS u32x2*)(pp + 48) = (u32x2){w1.z, w1.w};
                        }
                        ldsp vb = Vs + (32 * st + 4 * h + qsub) * VRS + (16 * blk + 4 * p4) * 2;
                        acc = MFMA32(cat8(lds_tr(vb), lds_tr(vb + 8 * VRS)), P0, acc);
                        acc = MFMA32(cat8(lds_tr(vb + 16 * VRS), lds_tr(vb + 24 * VRS)), P1, acc);
                    }
                    rstot = rowsum + __shfl_xor(rowsum, 32);
                    if (h == 0) XS[l31] = rstot;
                    asm volatile("s_waitcnt lgkmcnt(0)" ::: "memory");
                    if (lane == 0) *flagP = (unsigned)(i + 1);
                    while (*flagQ != (unsigned)(i + 1)) __builtin_amdgcn_s_sleep(1);
                    asm volatile("s_waitcnt lgkmcnt(0)" ::: "memory");
#pragma unroll
                    for (int g4 = 0; g4 < 4; ++g4) { const f32x4 x = *(LAS const f32x4*)(XQ + (g4 * 64 + lane) * 16); acc2[4 * g4] = x[0]; acc2[4 * g4 + 1] = x[1]; acc2[4 * g4 + 2] = x[2]; acc2[4 * g4 + 3] = x[3]; }
                    qn = XS[32 + l31];
                } else {
                    f32x16 accA, acc3;
#pragma unroll
                    for (int q = 0; q < 16; ++q) { accA[q] = 0.f; acc2[q] = 0.f; acc3[q] = 0.f; }
#pragma unroll
                    for (int ks = 0; ks < 8; ++ks) accA = MFMA32(*(const LAS bf16x8*)(Cs + l31 * QRS + (16 * ks + 8 * h) * 2), Qf[ks], accA);
#pragma unroll
                    for (int ks = 0; ks < 8; ++ks) acc3 = MFMA32(*(const LAS bf16x8*)(Cs + (64 + l31) * QRS + (16 * ks + 8 * h) * 2), Qf[ks], acc3);
#pragma unroll
                    for (int g4 = 0; g4 < 4; ++g4) *(LAS f32x4*)(XQ + (g4 * 64 + lane) * 16) = (f32x4){accA[4 * g4], accA[4 * g4 + 1], accA[4 * g4 + 2], accA[4 * g4 + 3]};
                    if (h == 0) XS[32 + l31] = acc3[0];
                    asm volatile("s_waitcnt lgkmcnt(0)" ::: "memory");
                    if (lane == 0) *flagQ = (unsigned)(i + 1);
#pragma unroll
                    for (int ks = 0; ks < 8; ++ks) acc2 = MFMA32(*(const LAS bf16x8*)(Cs + (32 + l31) * QRS + (16 * ks + 8 * h) * 2), Qf[ks], acc2);
                    qn = __shfl(acc3[0], l31);
                    while (*flagP != (unsigned)(i + 1)) __builtin_amdgcn_s_sleep(1);
                    asm volatile("s_waitcnt lgkmcnt(0)" ::: "memory");
#pragma unroll
                    for (int st = 0; st < 2; ++st) {
                        if (dir == 0 ? (st > tt) : (st < tt)) continue;
#pragma unroll
                        for (int s2 = 0; s2 < 2; ++s2) {
                            const bf16x8 Pf = *(const LAS bf16x8*)(XP + l31 * 144 + (32 * st + 16 * s2 + 8 * h) * 2);
                            ldsp vb2 = Vs + (32 * st + 16 * s2 + 8 * h + qsub) * VRS + (32 + 16 * blk + 4 * p4) * 2;
                            acc = MFMA32(cat8(lds_tr(vb2), lds_tr(vb2 + 4 * VRS)), Pf, acc);
                        }
                    }
                    rstot = XS[l31];
                }
#pragma unroll
                for (int q = 0; q < 16; ++q) acc[q] = ft * acc[q] + sc * acc2[q];
                const float den = ft * rstot + sc * qn;
                const float inv = 1.f / fmaxf(fabsf(den), em);
                bf16_t* hp = (Hout + (base + (size_t)chunk * 64) * 1024 + head * 256 + sl * 64) + (unsigned)(t * 1024 + 32 * vt + 4 * h);
#pragma unroll
                for (int gq = 0; gq < 4; ++gq) {
                    u32x2 w; w.x = pk2(acc[4 * gq] * inv, acc[4 * gq + 1] * inv); w.y = pk2(acc[4 * gq + 2] * inv, acc[4 * gq + 3] * inv);
                    *(u32x2*)(hp + 8 * gq) = w;
                }
                mc = b_end + fmaxf(mc, pm_all);
            }
        } else {
            const int w2 = wave - 4, tid2 = tid - 256;
            float mc = -1e30f;
            f32x16 c0, c1, nacc;
#pragma unroll
            for (int i = 0; i < 16; ++i) { c0[i] = 0.f; c1[i] = 0.f; nacc[i] = 0.f; }
            u32x4 rq0, rq1, rq2, rq3, rk0, rk1, rk2, rk3, pv0, pv1; f32x4 pg = {0.f, 0.f, 0.f, 0.f};
            ML_LOAD(dir ? NC - 1 : 0);
            ML_STORE(0);
            ML_LOAD(dir ? NC - 2 : 1);
            for (int i = 0; i < NC; ++i) {
                const int par = i & 1;
                __syncthreads();
                if (i + 1 < NC) ML_STORE(par ^ 1);
                if (i + 2 < NC) ML_LOAD(dir ? NC - 3 - i : i + 2);
                ldsp Qs = lds + ML_Q + par * 17408, Ks = lds + ML_K + par * 17408, Vs = lds + ML_V + par * 9216;
                LAS const float* gb = (LAS const float*)(lds + ML_GB + par * ML_GBSZ);
                const float b_end = gb[192], pm_all = gb[193];
                const float mxa = fmaxf(mc, pm_all), sp = __expf(mc - mxa), su = __expf(pm_all - mxa);
#pragma unroll
                for (int q = 0; q < 16; ++q) { c0[q] *= sp; c1[q] *= sp; nacc[q] *= sp; }
                const bf16x8 ONES = {(short)0x3F80, (short)0x3F80, (short)0x3F80, (short)0x3F80, (short)0x3F80, (short)0x3F80, (short)0x3F80, (short)0x3F80};
#pragma unroll
                for (int s2 = 0; s2 < 4; ++s2) {
                    ldsp kb2 = Ks + (16 * s2 + 8 * h + qsub) * QRS + (32 * w2 + 16 * blk + 4 * p4) * 2;
                    const s16x4 klo = lds_tr(kb2), khi = lds_tr(kb2 + 4 * QRS);
                    const f32x4 a0 = *(LAS const f32x4*)(gb + 64 + 16 * s2 + 8 * h), a1 = *(LAS const f32x4*)(gb + 64 + 16 * s2 + 8 * h + 4);
                    const bf16x8 Au = pack8(bf_s(klo[0]) * (a0[0] * su), bf_s(klo[1]) * (a0[1] * su), bf_s(klo[2]) * (a0[2] * su), bf_s(klo[3]) * (a0[3] * su),
                                            bf_s(khi[0]) * (a1[0] * su), bf_s(khi[1]) * (a1[1] * su), bf_s(khi[2]) * (a1[2] * su), bf_s(khi[3]) * (a1[3] * su));
                    ldsp vb2 = Vs + (16 * s2 + 8 * h + qsub) * VRS + (16 * blk + 4 * p4) * 2;
                    const bf16x8 B0 = cat8(lds_tr(vb2), lds_tr(vb2 + 4 * VRS));
                    const bf16x8 B1 = cat8(lds_tr(vb2 + 64), lds_tr(vb2 + 4 * VRS + 64));
                    c0 = MFMA32(Au, B0, c0); c1 = MFMA32(Au, B1, c1); nacc = MFMA32(Au, ONES, nacc);
                }
                {
                    ldsp Cw = lds + ML_C + (par ^ 1) * ML_CSZ;
#pragma unroll
                    for (int gq = 0; gq < 4; ++gq) {
                        const int d0 = 32 * w2 + 8 * gq + 4 * h;
                        u32x2 w; w.x = pk2(c0[4 * gq], c0[4 * gq + 1]); w.y = pk2(c0[4 * gq + 2], c0[4 * gq + 3]);
                        *(LAS u32x2*)(Cw + l31 * QRS + d0 * 2) = w;
                        w.x = pk2(c1[4 * gq], c1[4 * gq + 1]); w.y = pk2(c1[4 * gq + 2], c1[4 * gq + 3]);
                        *(LAS u32x2*)(Cw + (32 + l31) * QRS + d0 * 2) = w;
                        if (l31 == 0) { w.x = pk2(nacc[4 * gq], nacc[4 * gq + 1]); w.y = pk2(nacc[4 * gq + 2], nacc[4 * gq + 3]); *(LAS u32x2*)(Cw + 64 * QRS + d0 * 2) = w; }
                    }
                }
                mc = b_end + fmaxf(mc, pm_all);
            }
        }
#undef ML_LOAD
#undef ML_STORE
#undef ML_LD1
#undef ML_ST1
    }
    if (G >= 128 && first >= 64) {
        unsigned* cnt = (unsigned*)a.ws + 3520 + 64 * j;
        asm volatile("s_waitcnt vmcnt(0)" ::: "memory");
        __syncthreads();
        if (tid == 0) {
            __builtin_amdgcn_fence(__ATOMIC_RELEASE, "agent");
            asm volatile("s_waitcnt vmcnt(0)" ::: "memory");
            (void)__hip_atomic_fetch_add(cnt, 1u, __ATOMIC_RELAXED, __HIP_MEMORY_SCOPE_AGENT);
            unsigned sp = 0;
            while (__hip_atomic_load(cnt, __ATOMIC_RELAXED, __HIP_MEMORY_SCOPE_AGENT) < (unsigned)(G - 64)) { __builtin_amdgcn_s_sleep(2); if (++sp > (1u << 22)) break; }
            __builtin_amdgcn_fence(__ATOMIC_ACQUIRE, "agent");
            asm volatile("s_waitcnt vmcnt(0)" ::: "memory");
        }
        __syncthreads();
        hn_phase(a, j, NPROMPT, MTOK, first - 64, G - 64);
    }
}


__device__ __forceinline__ void hn_phase(const Args& a, int j, int row_lo, int row_hi, int bidx, int nblk) {
    const int tid_ = opaque_tid(); const int lane = tid_ & 63, wave = tid_ >> 6;
    const bf16_t* HF = (const bf16_t*)(a.ws + WS_R0);
    const bf16_t* HB = (const bf16_t*)(a.ws + WS_R0 + 4 * RSZ);
    const bf16_t* GG = (const bf16_t*)(a.ws + WS_R0 + 3 * RSZ);
    bf16_t* MO = (bf16_t*)(a.ws + WS_R0 + 2 * RSZ);
    const float* hn = a.in[8] + j * 1024 + 16 * lane;
    const f32x4 w0 = *(const f32x4*)(hn), w1 = *(const f32x4*)(hn + 4), w2 = *(const f32x4*)(hn + 8), w3 = *(const f32x4*)(hn + 12);
    for (int row = row_lo + bidx * 8 + wave; row < row_hi; row += nblk * 8) {
        const size_t off = (size_t)row * 1024 + 16 * lane;
        const u32x4 f0 = *(const u32x4*)(HF + off), f1 = *(const u32x4*)(HF + off + 8);
        const u32x4 b0 = *(const u32x4*)(HB + off), b1 = *(const u32x4*)(HB + off + 8);
        const u32x4 g0 = *(const u32x4*)(GG + off), g1 = *(const u32x4*)(GG + off + 8);
        float x0 = bf_lo(f0.x) + bf_lo(b0.x), x1 = bf_hi(f0.x) + bf_hi(b0.x), x2 = bf_lo(f0.y) + bf_lo(b0.y), x3 = bf_hi(f0.y) + bf_hi(b0.y);
        float x4 = bf_lo(f0.z) + bf_lo(b0.z), x5 = bf_hi(f0.z) + bf_hi(b0.z), x6 = bf_lo(f0.w) + bf_lo(b0.w), x7 = bf_hi(f0.w) + bf_hi(b0.w);
        float y0 = bf_lo(f1.x) + bf_lo(b1.x), y1 = bf_hi(f1.x) + bf_hi(b1.x), y2 = bf_lo(f1.y) + bf_lo(b1.y), y3 = bf_hi(f1.y) + bf_hi(b1.y);
        float y4 = bf_lo(f1.z) + bf_lo(b1.z), y5 = bf_hi(f1.z) + bf_hi(b1.z), y6 = bf_lo(f1.w) + bf_lo(b1.w), y7 = bf_hi(f1.w) + bf_hi(b1.w);
        float ss = x0 * x0 + x1 * x1 + x2 * x2 + x3 * x3 + x4 * x4 + x5 * x5 + x6 * x6 + x7 * x7 + y0 * y0 + y1 * y1 + y2 * y2 + y3 * y3 + y4 * y4 + y5 * y5 + y6 * y6 + y7 * y7;
        ss += __shfl_xor(ss, 1); ss += __shfl_xor(ss, 2); ss += __shfl_xor(ss, 4); ss += __shfl_xor(ss, 8);
        const float rs = rsqrtf(ss * (1.f / 256.f) + 1e-6f);
        u32x4 o0, o1;
        o0.x = pk2(x0 * rs * w0[0] * bf_lo(g0.x), x1 * rs * w0[1] * bf_hi(g0.x)); o0.y = pk2(x2 * rs * w0[2] * bf_lo(g0.y), x3 * rs * w0[3] * bf_hi(g0.y));
        o0.z = pk2(x4 * rs * w1[0] * bf_lo(g0.z), x5 * rs * w1[1] * bf_hi(g0.z)); o0.w = pk2(x6 * rs * w1[2] * bf_lo(g0.w), x7 * rs * w1[3] * bf_hi(g0.w));
        o1.x = pk2(y0 * rs * w2[0] * bf_lo(g1.x), y1 * rs * w2[1] * bf_hi(g1.x)); o1.y = pk2(y2 * rs * w2[2] * bf_lo(g1.y), y3 * rs * w2[3] * bf_hi(g1.y));
        o1.z = pk2(y4 * rs * w3[0] * bf_lo(g1.z), y5 * rs * w3[1] * bf_hi(g1.z)); o1.w = pk2(y6 * rs * w3[2] * bf_lo(g1.w), y7 * rs * w3[3] * bf_hi(g1.w));
        *(u32x4*)(MO + off) = o0; *(u32x4*)(MO + off + 8) = o1;
    }
}

#define XB_TMO      128
#define XB_XCNT(j)  (256  + 64 * (j))
#define XB_XSUB(j)  (1280 + 64 * (j))
#define XB_XGEN(j)  (2304 + 64 * (j))
#define XB_TOP      3328
#define XB_TOPGEN   3392
#define XCD_BAR_WORDS 3456
#define XB_SPIN_CAP (1u << 18)

__device__ __forceinline__ unsigned xb_ld(unsigned* p)              { return __hip_atomic_load(p, __ATOMIC_RELAXED, __HIP_MEMORY_SCOPE_AGENT); }
__device__ __forceinline__ unsigned xb_add(unsigned* p, unsigned v) { return __hip_atomic_fetch_add(p, v, __ATOMIC_RELAXED, __HIP_MEMORY_SCOPE_AGENT); }
__device__ __forceinline__ unsigned xb_xcc_id() { return (unsigned)__builtin_amdgcn_s_getreg((3 << 11) | 20) & 0xFu; }
#define XB_SPIN(cond, bar) do { unsigned _sp = 0; while (cond) { __builtin_amdgcn_s_sleep(1); \
    if ((++_sp & 255u) == 0u) { if (xb_ld(&(bar)[XB_TMO])) break; if (_sp > XB_SPIN_CAP) { atomicAdd(&(bar)[XB_TMO], 1u); break; } } } } while (0)

struct XcdBarrier {
    unsigned* bar; unsigned x;
    volatile LAS unsigned* st;
};

__device__ __forceinline__ XcdBarrier xcd_barrier_post(unsigned* bar, volatile LAS unsigned* st) {
    XcdBarrier b; b.bar = bar; b.x = xb_xcc_id(); b.st = st;
    if (threadIdx.x == 0) (void)xb_add(&bar[XB_XCNT(b.x)], 1u);
    return b;
}
__device__ __forceinline__ void xcd_barrier_complete(unsigned* bar, unsigned x, unsigned& nloc, unsigned& nx) {
    const unsigned G = gridDim.x * gridDim.y * gridDim.z;
    unsigned sum, cnt, mine, sp = 0u;
    for (;;) {
        sum = 0u; cnt = 0u; mine = 0u;
#pragma unroll
        for (unsigned j = 0; j < 16; ++j) { const unsigned c = xb_ld(&bar[XB_XCNT(j)]); sum += c; cnt += (c > 0u) ? 1u : 0u; mine = (j == x) ? c : mine; }
        if (sum == G) break;
        __builtin_amdgcn_s_sleep(1);
        if ((++sp & 255u) == 0u) { if (xb_ld(&bar[XB_TMO])) break; if (sp > XB_SPIN_CAP) { atomicAdd(&bar[XB_TMO], 1u); break; } }
    }
    nloc = mine > 0u ? mine : 1u; nx = cnt > 0u ? cnt : 1u;
}

__device__ __forceinline__ void xcd_barrier(const XcdBarrier& b) {
    asm volatile("s_waitcnt vmcnt(0)" ::: "memory");
    __syncthreads();
    if (threadIdx.x == 0) {
        unsigned* bar = b.bar;
        __builtin_amdgcn_s_waitcnt(0);
        unsigned nloc = b.st[0], nx = b.st[1];
        if (nloc == 0u) { xcd_barrier_complete(bar, b.x, nloc, nx); b.st[0] = nloc; b.st[1] = nx; }
        const unsigned old = xb_add(&bar[XB_XSUB(b.x)], 1u);
        const unsigned gen = old / nloc;
        if (old + 1u == (gen + 1u) * nloc) {
            __builtin_amdgcn_fence(__ATOMIC_RELEASE, "agent");
            asm volatile("s_waitcnt vmcnt(0)" ::: "memory");
            const unsigned og = xb_add(&bar[XB_TOP], 1u);
            const unsigned tg = og / nx;
            if (og + 1u == (tg + 1u) * nx) xb_add(&bar[XB_TOPGEN], 1u);
            else XB_SPIN(xb_ld(&bar[XB_TOPGEN]) == tg, bar);
            __builtin_amdgcn_fence(__ATOMIC_ACQUIRE, "agent");
            xb_add(&bar[XB_XGEN(b.x)], 1u);
            asm volatile("s_waitcnt vmcnt(0)" ::: "memory");
        } else {
            XB_SPIN(xb_ld(&bar[XB_XGEN(b.x)]) == gen, bar);
            __builtin_amdgcn_fence(__ATOMIC_ACQUIRE, "agent");
            asm volatile("s_waitcnt vmcnt(0)" ::: "memory");
        }
    }
    __syncthreads();
}

__global__ void __launch_bounds__(512, 2) fwd_kernel(Args a) {
    extern __shared__ __attribute__((aligned(16))) unsigned char lds_raw[];
    ldsp lds = (ldsp)lds_raw;
    cg::grid_group grid = cg::this_grid();
    const int G = gridDim.x;
    volatile LAS unsigned* bst = (volatile LAS unsigned*)(lds + LDS_BYTES - 64);
    if (threadIdx.x < 2) bst[threadIdx.x] = 0u;
    __syncthreads();
    const XcdBarrier xbar = xcd_barrier_post((unsigned*)a.ws, bst);
    for (int ph = a.ph_lo; ph < a.ph_hi; ++ph) {
        if (ph == 0) { prep_phase(a, lds, G); norm_phase(a, 0, G); }
        else if (ph == NPHASE - 1) { norm_phase(a, 2, G); }
        else {
            const int p = ph - 1, j = p >> 3, r = p & 7;
            bf16_t* R0 = (bf16_t*)(a.ws + WS_R0);
            bf16_t* R1 = (bf16_t*)(a.ws + WS_R0 + 1 * RSZ);
            bf16_t* R2 = (bf16_t*)(a.ws + WS_R0 + 2 * RSZ);
            bf16_t* R3 = (bf16_t*)(a.ws + WS_R0 + 3 * RSZ);
            bf16_t* R4 = (bf16_t*)(a.ws + WS_R0 + 4 * RSZ);
            u64_t* SS = (u64_t*)(a.ws + WS_SS);
            if (r == 0) { for (int rep = 0; rep < DUP(1); ++rep) {
                pg8::Gemm g{R0, (const bf16_t*)(a.ws + WS_WA + j * WA_SZ), MTOK, 2560, 1024};
                pg8::StaticOrder S; S.init(MTOK, 2560, G, opaque_bid());
                pg8::EpiAttnIn E{R1, R2, R2 + (size_t)MTOK * 256, R3, (const float*)(a.ws + WS_ROPE), SS + (size_t)(2 * j) * MTOK};
                pg8::gemm_phase<pg8::EpiAttnIn, pg8::StaticOrder, true, true>(lds, g, S, E); }
            } else if (r == 1) { for (int rep = 0; rep < DUP(2); ++rep) attn_phase(a, lds, j, G); }
            else if (r == 2 || r == 7) {
                const int lnext = 2 * j + (r == 2 ? 1 : 2);
                pg8::Gemm g{r == 2 ? R4 : R2, (const bf16_t*)(a.ws + (r == 2 ? WS_WAO : WS_WMO) + j * WO_SZ), MTOK, 1024, 1024};
                pg8::StaticOrder S; S.init(MTOK, 1024, G, opaque_bid());
                pg8::EpiResid E{ph == 3 ? a.in[0] : nullptr, ph == 3 ? a.in[1] : nullptr, a.out, R0, lnext < 4 ? SS + (size_t)lnext * MTOK : nullptr};
                pg8::gemm_phase<pg8::EpiResid, pg8::StaticOrder, true, true>(lds, g, S, E);
            } else if (r == 3) { for (int rep = 0; rep < DUP(5); ++rep) {
                pg8::Gemm g{R0, (const bf16_t*)(a.ws + WS_WM + j * WM_SZ), MTOK, 4352, 1024};
                pg8::StaticOrder S; S.init(MTOK, 4352, G, opaque_bid());
                pg8::EpiMlstmIn E{R1, R1 + (size_t)MTOK * 512, R2, R3, (float*)(a.ws + WS_GATES), a.in[7] + j * 16, SS + (size_t)(2 * j + 1) * MTOK};
                pg8::gemm_phase<pg8::EpiMlstmIn, pg8::StaticOrder, true, true>(lds, g, S, E); }
            } else if (r == 4) { gatescan_phase(a, G); }
            else if (r == 5) { mlstm_phase(a, lds, j, G); }
            else { if (G >= 128) hn_phase(a, j, 0, NPROMPT, opaque_bid(), G); else hn_phase(a, j, 0, MTOK, opaque_bid(), G); }
        }
        if (ph + 1 < a.ph_hi) {
            if (a.ph_hi > NPHASE) grid.sync();
            else xcd_barrier(xbar);
#ifdef DUP_SYNC
            xcd_barrier(xbar); xcd_barrier(xbar);
#endif
        }
    }
}

extern "C" void kernel_launch(void* const* d_in, const int* in_sizes, int n_in, void* d_out, int out_size, void* d_ws, size_t ws_size, hipStream_t stream) {
    static int grid = 0;
    if (grid == 0) {
        if (n_in != 11 || out_size != MTOK * DM || ws_size < WS_END) { fprintf(stderr, "kernel_launch: unexpected problem (n_in %d, out %d, ws %zu; need ws >= %zu)\n", n_in, out_size, ws_size, (size_t)WS_END); grid = -1; return; }
        int dev = 0, cus = 0, per_cu = 0;
        if (hipGetDevice(&dev) != hipSuccess || hipDeviceGetAttribute(&cus, hipDeviceAttributeMultiprocessorCount, dev) != hipSuccess) { grid = -1; return; }
        if (hipFuncSetAttribute((const void*)fwd_kernel, hipFuncAttributeMaxDynamicSharedMemorySize, LDS_BYTES) != hipSuccess) { fprintf(stderr, "kernel_launch: hipFuncSetAttribute failed\n"); grid = -1; return; }
        if (hipOccupancyMaxActiveBlocksPerMultiprocessor(&per_cu, (const void*)fwd_kernel, 512, LDS_BYTES) != hipSuccess || per_cu < 1) { fprintf(stderr, "kernel_launch: occupancy query says %d\n", per_cu); (void)hipGetLastError(); per_cu = 1; }
        grid = cus * per_cu;
    }
    if (grid < 0) return;
    if (hipMemsetAsync(d_ws, 0, 16384, stream) != hipSuccess) { fprintf(stderr, "kernel_launch: memset failed\n"); return; }
    Args a{};
    for (int i = 0; i < 11; ++i) a.in[i] = (const float*)d_in[i];
    a.out = (float*)d_out; a.ws = (unsigned char*)d_ws;
#if MK_MULTI
    for (int ph = 0; ph < NPHASE; ++ph) { a.ph_lo = ph; a.ph_hi = ph + 1; hipLaunchKernelGGL(fwd_kernel, dim3(grid), dim3(512), LDS_BYTES, stream, a); }
#else
    a.ph_lo = 0; a.ph_hi = NPHASE;
    void* args[] = {&a};
    hipError_t e = hipLaunchCooperativeKernel((void*)fwd_kernel, dim3(grid), dim3(512), args, LDS_BYTES, stream);
    if (e != hipSuccess) fprintf(stderr, "kernel_launch: cooperative launch failed: %s (grid %d)\n", hipGetErrorString(e), grid);
#endif
}
```

```cpp
#include <hip/hip_runtime.h>
#include <hip/hip_cooperative_groups.h>
#include <cstdio>
#include <cstdint>
namespace cg = cooperative_groups;
#define MK_MULTI 0
__device__ __forceinline__ int opaque_tid() { int t = threadIdx.x; asm volatile("" : "+v"(t)); return t; }
__device__ __forceinline__ int opaque_bid() { int t = blockIdx.x; asm volatile("" : "+s"(t)); return t; }
namespace pg8 {
#define PG8_LAS __attribute__((address_space(3)))
typedef unsigned short bf16_t;
typedef short bf16x8 __attribute__((ext_vector_type(8)));
typedef float f32x4 __attribute__((ext_vector_type(4)));
typedef unsigned u32x4 __attribute__((ext_vector_type(4)));
constexpr int BM = 256, BK = 64, HALF = 128, HTB = HALF * BK * 2  , STAGE_BYTES = 8 * HTB, NXCD = 8, WGM = 8;

__host__ __device__ __forceinline__ int lds_byte(int r, int c) { const int st = (r >> 4) * 2 + (c >> 5), rr = r & 15, cc = c & 31, ob = rr * 64 + cc * 2; return st * 1024 + (ob ^ (((ob >> 9) & 1) << 5)); }
__host__ __device__ __forceinline__ void stage_rc(int b, int& R, int& C) { const int st = b / 1024, sb = b % 1024, swz = sb ^ (((sb >> 9) & 1) << 5); R = (st >> 1) * 16 + swz / 64; C = (st & 1) * 32 + (swz % 64) / 2; }
__host__ __device__ __forceinline__ int perm32(int rho) { const int n = rho >> 4, i = rho & 15; return 8 * (i >> 2) + 4 * n + (i & 3); }

struct Unit { int pm, pn; };
struct Gemm { const bf16_t* A; const bf16_t* Bt; int M, N, K; };

struct StaticOrder {
    int nM, nN, nwg, G, c;
    __host__ __device__ void init(int M, int N, int G_, int c_) { nM = M / BM; nN = N / BM; nwg = nM * nN; G = G_; c = c_; }
    __host__ __device__ bool next(int i, Unit& u) const {
        const long L = (long)i * G + c; if (L >= nwg) return false;
        int wgid = (int)L; { const int q = nwg / NXCD, r = nwg % NXCD, xcd = wgid % NXCD, off = wgid / NXCD; wgid = (xcd < r ? xcd * (q + 1) : r * (q + 1) + (xcd - r) * q) + off; }
        const int nig = WGM * nN, gid = wgid / nig, fm = gid * WGM, gsz = (nM - fm) < WGM ? (nM - fm) : WGM;
        u.pm = fm + ((wgid % nig) % gsz); u.pn = (wgid % nig) / gsz; return true;
    }
    __device__ __forceinline__ void a_ready(const Unit&) const {}
    __device__ __forceinline__ void done(const Unit&) const {}
};

__device__ __forceinline__ unsigned cvt_pk_bf16(float lo, float hi) { unsigned r; asm volatile("v_cvt_pk_bf16_f32 %0, %1, %2" : "=v"(r) : "v"(lo), "v"(hi)); return r; }
typedef float f32x2 __attribute__((ext_vector_type(2)));

template <class Epi, class Sched, bool ALIGN_EPI = false, bool SP2 = false>
__device__ __forceinline__ void gemm_phase(PG8_LAS unsigned char* lds, const Gemm g, const Sched& S, const Epi& E) {
    const int tid = opaque_tid(), wid = __builtin_amdgcn_readfirstlane(tid >> 6), lane = tid & 63, wr = wid >> 2, wc = wid & 3, fr = lane & 15, fq = lane >> 4;
    const int K = g.K, nt = K / BK;
    unsigned voffA[2], voffB[2];
#pragma unroll
    for (int i = 0; i < 2; ++i) { int R, C; stage_rc(tid * 16 + i * 8192, R, C); const int Rb = Epi::PERM ? ((R & ~31) + perm32(R & 31)) : R;
        voffA[i] = (unsigned)(R * K + C) * 2u; voffB[i] = (unsigned)(Rb * K + C) * 2u; }
    const size_t kstep = (size_t)(BK * 2);
    const size_t hstep = (size_t)HALF * K * 2;
    const size_t tstep = 2 * hstep;
    const unsigned ldsw = (unsigned)wid * 1024u;
    const int aoff = lds_byte(wr * 64 + fr, fq * 8), boff = lds_byte(wc * 32 + fr, fq * 8);
#define PG8_SA(b, h) (((b) * 2 + (h)) * HTB)
#define PG8_SB(b, h) ((4 + (b) * 2 + (h)) * HTB)
#define PG8_STAGE(bufoff, gbase, voff) do { _Pragma("unroll") for (int _i = 0; _i < 2; ++_i) \
        __builtin_amdgcn_global_load_lds((const unsigned*)((const char*)(gbase) + (voff)[_i]), (PG8_LAS unsigned*)(lds + (bufoff) + ldsw + _i * 8192), 16, 0, 0); } while (0)
#define PG8_LDA(dst, b, h) do { _Pragma("unroll") for (int m = 0; m < 4; ++m) _Pragma("unroll") for (int k = 0; k < 2; ++k) dst[m][k] = *(const PG8_LAS bf16x8*)(lds + PG8_SA(b, h) + aoff + m * 2048 + k * 1024); } while (0)
#define PG8_LDB(dst, b, h) do { _Pragma("unroll") for (int n = 0; n < 2; ++n) _Pragma("unroll") for (int k = 0; k < 2; ++k) dst[n][k] = *(const PG8_LAS bf16x8*)(lds + PG8_SB(b, h) + boff + n * 2048 + k * 1024); } while (0)
#define PG8_MMA(ai, bj, At, Bt) do { __builtin_amdgcn_s_setprio(1); _Pragma("unroll") for (int m = 0; m < 4; ++m) _Pragma("unroll") for (int n = 0; n < 2; ++n) _Pragma("unroll") for (int k = 0; k < 2; ++k) \
        acc[ai][bj][m][n] = __builtin_amdgcn_mfma_f32_16x16x32_bf16(Bt[n][k], At[m][k], acc[ai][bj][m][n], 0, 0, 0); __builtin_amdgcn_s_setprio(0); } while (0)
#define PG8_WAIT_V(n) asm volatile("s_waitcnt vmcnt(" #n ")" ::: "memory")
#define PG8_WAIT_L(n) asm volatile("s_waitcnt lgkmcnt(" #n ")" ::: "memory")
#define PG8_BAR __builtin_amdgcn_s_barrier()
#define PG8_SCHED __builtin_amdgcn_sched_barrier(0)
    Unit cur, nxt; int ui = 0;
    if (!S.next(0, cur)) return;
    f32x4 acc[2][2][4][2];
#pragma unroll
    for (int a = 0; a < 2; ++a)
#pragma unroll
        for (int b = 0; b < 2; ++b)
#pragma unroll
            for (int m = 0; m < 4; ++m)
#pragma unroll
                for (int n = 0; n < 2; ++n) acc[a][b][m][n] = (f32x4){0.f, 0.f, 0.f, 0.f};
    bf16x8 At[4][2], B0[2][2], B1[2][2];
    const char* cA = (const char*)g.A + (size_t)cur.pm * tstep; const char* cB = (const char*)g.Bt + (size_t)cur.pn * tstep;
    S.a_ready(cur);
    if constexpr (SP2) {
        PG8_STAGE(PG8_SB(0, 0), cB, voffB); PG8_STAGE(PG8_SB(0, 1), cB + hstep, voffB); PG8_STAGE(PG8_SA(0, 0), cA, voffA); PG8_STAGE(PG8_SA(0, 1), cA + hstep, voffA);
        if (wr == 1) PG8_BAR;
        PG8_WAIT_V(2); PG8_BAR;
        PG8_STAGE(PG8_SB(1, 0), cB + kstep, voffB); PG8_STAGE(PG8_SA(1, 0), cA + kstep, voffA); PG8_STAGE(PG8_SB(1, 1), cB + hstep + kstep, voffB);
        PG8_WAIT_V(6); PG8_BAR;
    } else {
        PG8_STAGE(PG8_SB(0, 0), cB, voffB); PG8_STAGE(PG8_SA(0, 0), cA, voffA); PG8_STAGE(PG8_SB(0, 1), cB + hstep, voffB); PG8_STAGE(PG8_SA(0, 1), cA + hstep, voffA);
        if (wr == 1) PG8_BAR;
        PG8_WAIT_V(4); PG8_BAR;
        PG8_STAGE(PG8_SB(1, 0), cB + kstep, voffB); PG8_STAGE(PG8_SA(1, 0), cA + kstep, voffA); PG8_STAGE(PG8_SB(1, 1), cB + hstep + kstep, voffB);
        PG8_WAIT_V(6); PG8_BAR;
    }
    for (;;) {
        const bool has_next = S.next(ui + 1, nxt);
        const char* nA = has_next ? (const char*)g.A + (size_t)nxt.pm * tstep : cA; const char* nB = has_next ? (const char*)g.Bt + (size_t)nxt.pn * tstep : cB;
        for (int t = 0; t < nt; t += 2) {
            const bool last = (t == nt - 2);
            const char* a1 = cA + (size_t)(t + 1) * kstep;
            const char* a2 = last ? nA : cA + (size_t)(t + 2) * kstep; const char* b2 = last ? nB : cB + (size_t)(t + 2) * kstep;
            const char* a3 = a2 + kstep; const char* b3 = b2 + kstep;
            if (last && has_next) S.a_ready(nxt);
            if constexpr (SP2) {
            PG8_LDB(B0, 0, 0); PG8_LDB(B1, 0, 1); PG8_SCHED; PG8_LDA(At, 0, 0); PG8_STAGE(PG8_SA(1, 1), a1 + hstep, voffA);
            PG8_WAIT_V(8); PG8_WAIT_L(0); PG8_BAR; PG8_MMA(0, 0, At, B0); PG8_MMA(0, 1, At, B1); PG8_BAR; PG8_SCHED;
            PG8_LDA(At, 0, 1); PG8_STAGE(PG8_SB(0, 0), b2, voffB); PG8_STAGE(PG8_SB(0, 1), b2 + hstep, voffB); PG8_STAGE(PG8_SA(0, 0), a2, voffA);
            PG8_WAIT_V(8); PG8_WAIT_L(0); PG8_BAR; PG8_MMA(1, 0, At, B0); PG8_MMA(1, 1, At, B1); PG8_BAR; PG8_SCHED;
            PG8_LDB(B0, 1, 0); PG8_LDB(B1, 1, 1); PG8_SCHED; PG8_LDA(At, 1, 0); PG8_STAGE(PG8_SA(0, 1), a2 + hstep, voffA);
            PG8_WAIT_V(8); PG8_WAIT_L(0); PG8_BAR; PG8_MMA(0, 0, At, B0); PG8_MMA(0, 1, At, B1); PG8_BAR; PG8_SCHED;
            PG8_LDA(At, 1, 1); PG8_STAGE(PG8_SB(1, 0), b3, voffB); PG8_STAGE(PG8_SB(1, 1), b3 + hstep, voffB); PG8_STAGE(PG8_SA(1, 0), a3, voffA);
            PG8_WAIT_V(8); PG8_WAIT_L(0); PG8_BAR; PG8_MMA(1, 0, At, B0); PG8_MMA(1, 1, At, B1); PG8_BAR; PG8_SCHED;
            } else {
            PG8_LDB(B0, 0, 0); PG8_SCHED; PG8_LDA(At, 0, 0); PG8_STAGE(PG8_SA(1, 1), a1 + hstep, voffA);
            PG8_WAIT_L(8); PG8_BAR; PG8_WAIT_L(0); PG8_MMA(0, 0, At, B0); PG8_BAR; PG8_SCHED;
            PG8_LDB(B1, 0, 1); PG8_STAGE(PG8_SB(0, 0), b2, voffB);
            PG8_BAR; PG8_WAIT_L(0); PG8_MMA(0, 1, At, B1); PG8_BAR;
            PG8_LDA(At, 0, 1); PG8_STAGE(PG8_SA(0, 0), a2, voffA);
            PG8_BAR; PG8_WAIT_L(0); PG8_MMA(1, 0, At, B0); PG8_BAR; PG8_SCHED;
            PG8_STAGE(PG8_SB(0, 1), b2 + hstep, voffB);
            PG8_WAIT_V(6); PG8_BAR; PG8_MMA(1, 1, At, B1); PG8_BAR;
            PG8_LDB(B0, 1, 0); PG8_SCHED; PG8_LDA(At, 1, 0); PG8_STAGE(PG8_SA(0, 1), a2 + hstep, voffA);
            PG8_WAIT_L(8); PG8_BAR; PG8_WAIT_L(0); PG8_MMA(0, 0, At, B0); PG8_BAR; PG8_SCHED;
            PG8_LDB(B1, 1, 1); PG8_STAGE(PG8_SB(1, 0), b3, voffB);
            PG8_BAR; PG8_WAIT_L(0); PG8_MMA(0, 1, At, B1); PG8_BAR;
            PG8_LDA(At, 1, 1); PG8_STAGE(PG8_SA(1, 0), a3, voffA);
            PG8_BAR; PG8_WAIT_L(0); PG8_MMA(1, 0, At, B0); PG8_BAR; PG8_SCHED;
            PG8_STAGE(PG8_SB(1, 1), b3 + hstep, voffB);
            PG8_WAIT_V(6); PG8_BAR; PG8_MMA(1, 1, At, B1); PG8_BAR;
            }
        }
        if constexpr (ALIGN_EPI) { if (wr == 0) PG8_BAR; }
        if constexpr (!Epi::AFTER_DRAIN) { E(acc, cur, wr, wc, fr, fq); S.done(cur); }
        if (!has_next) break;
#pragma unroll
        for (int a = 0; a < 2; ++a)
#pragma unroll
            for (int b = 0; b < 2; ++b)
#pragma unroll
                for (int m = 0; m < 4; ++m)
#pragma unroll
                    for (int n = 0; n < 2; ++n) acc[a][b][m][n] = (f32x4){0.f, 0.f, 0.f, 0.f};
        cur = nxt; cA = nA; cB = nB; ++ui;
        if constexpr (ALIGN_EPI) { if (wr == 1) PG8_BAR; }
    }
    PG8_WAIT_V(0);
    if constexpr (!ALIGN_EPI) { if (wr == 0) PG8_BAR; }
    PG8_BAR;
    if constexpr (Epi::AFTER_DRAIN) { E.fused(acc, cur, wr, wc, fr, fq, lds, wid, lane); S.done(cur); }
#undef PG8_SA
#undef PG8_SB
#undef PG8_STAGE
#undef PG8_LDA
#undef PG8_LDB
#undef PG8_MMA
#undef PG8_WAIT_V
#undef PG8_WAIT_L
#undef PG8_BAR
#undef PG8_SCHED
}
}

#ifndef EN_MASK
#define EN_MASK 0xff
#endif
#define EN(x) ((EN_MASK >> (x)) & 1)
#ifndef DUP_MASK
#define DUP_MASK 0
#endif
#define DUP(x) (((DUP_MASK >> (x)) & 1) ? 2 : 1)
#ifndef MK_MULTI
#define MK_MULTI 0
#endif
#define LAS __attribute__((address_space(3)))
typedef LAS unsigned char* ldsp;
typedef unsigned short bf16_t;
typedef short bf16x8 __attribute__((ext_vector_type(8)));
typedef short s16x4 __attribute__((ext_vector_type(4)));
typedef short v4i16_t __attribute__((ext_vector_type(4)));
typedef float f32x4 __attribute__((ext_vector_type(4)));
typedef float f32x16 __attribute__((ext_vector_type(16)));
typedef unsigned u32x4 __attribute__((ext_vector_type(4)));
typedef unsigned u32x2 __attribute__((ext_vector_type(2)));
typedef __bf16 bf16x2_t __attribute__((ext_vector_type(2)));
typedef float f32x2_t __attribute__((ext_vector_type(2)));

constexpr int MTOK = 98304, DM = 1024, NPROMPT = 32768, SEQ_P = 16384, SEQ_S = 2048;
constexpr size_t MiB = 1u << 20;
constexpr size_t WS_WA = 1 * MiB, WA_SZ = 5 * MiB;
constexpr size_t WS_WAO = 11 * MiB, WO_SZ = 2 * MiB;
constexpr size_t WS_WM = 15 * MiB, WM_SZ = 4352 * 1024 * 2;
constexpr size_t WS_WMO = 32 * MiB;
constexpr size_t WS_ROPE = 36 * MiB;
constexpr size_t WS_GATES = 40 * MiB;
constexpr size_t WS_R0 = 48 * MiB, RSZ = 192 * MiB;
constexpr size_t WS_GV = WS_R0 + 5 * RSZ;
constexpr size_t WS_SS = WS_GV + 10 * MiB;
constexpr size_t WS_END = WS_SS + 3 * MiB;
constexpr float SS_SCALE = 16777216.f, SS_INV = 1.f / (16777216.f * 1024.f);
typedef unsigned long long u64_t;
constexpr int LDS_BYTES = 163840;
constexpr int NPHASE = 18;
constexpr float LOG2E = 1.4426950408889634f;

struct Args { const float* in[11]; float* out; unsigned char* ws; int ph_lo, ph_hi; };

__device__ __forceinline__ unsigned pk2(float lo, float hi) { f32x2_t v = {lo, hi}; bf16x2_t b = __builtin_convertvector(v, bf16x2_t); return __builtin_bit_cast(unsigned, b); }
__device__ __forceinline__ float bf_lo(unsigned w) { return __builtin_bit_cast(float, w << 16); }
__device__ __forceinline__ float bf_hi(unsigned w) { return __builtin_bit_cast(float, w & 0xffff0000u); }
__device__ __forceinline__ float bf_s(short s) { return __builtin_bit_cast(float, ((unsigned)(unsigned short)s) << 16); }
__device__ __forceinline__ s16x4 lds_tr(ldsp p) { return __builtin_bit_cast(s16x4, __builtin_amdgcn_ds_read_tr16_b64_v4i16((LAS v4i16_t*)p)); }
__device__ __forceinline__ bf16x8 cat8(s16x4 lo, s16x4 hi) { bf16x8 r; r[0] = lo[0]; r[1] = lo[1]; r[2] = lo[2]; r[3] = lo[3]; r[4] = hi[0]; r[5] = hi[1]; r[6] = hi[2]; r[7] = hi[3]; return r; }
__device__ __forceinline__ bf16x8 pack8(float a0, float a1, float a2, float a3, float a4, float a5, float a6, float a7) {
    u32x4 w; w.x = pk2(a0, a1); w.y = pk2(a2, a3); w.z = pk2(a4, a5); w.w = pk2(a6, a7); return __builtin_bit_cast(bf16x8, w); }
__device__ __forceinline__ float fsigmoid(float x) { return __builtin_amdgcn_rcpf(1.f + __expf(-x)); }
#define MFMA32(a, b, c) __builtin_amdgcn_mfma_f32_32x32x16_bf16((a), (b), (c), 0, 0, 0)

namespace pg8 {
struct EpiAttnIn {
    static constexpr bool PERM = true, AFTER_DRAIN = false;
    bf16_t *Q, *K, *V, *Z; const float* rope; const u64_t* ss;
    __device__ __forceinline__ void operator()(const f32x4 (&acc)[2][2][4][2], const Unit& u, int wr, int wc, int fr, int fq) const {
        const int row0 = u.pm * BM + wr * 64 + fr, pn = u.pn;
        const int colb = pn * BM + wc * 32 + 8 * fq;
        float rsv[8];
#pragma unroll
        for (int i = 0; i < 8; ++i) rsv[i] = (float)ss[row0 + (i >> 2) * HALF + (i & 3) * 16];
#pragma unroll
        for (int i = 0; i < 8; ++i) rsv[i] = rsqrtf(rsv[i] * SS_INV + 1e-6f);
        if (pn < 5) {
            f32x4 cs[2][4];
            const int cofs = ((colb & 63) >> 1) * 2;
#define ROPE_LD(i, buf) do { const int row_ = row0 + ((i) >> 2) * HALF + ((i) & 3) * 16; const int pos_ = row_ < NPROMPT ? (row_ & (SEQ_P - 1)) : (row_ & (SEQ_S - 1)); \
            const float* p_ = rope + (size_t)pos_ * 64 + cofs; cs[buf][0] = *(const f32x4*)p_; cs[buf][1] = *(const f32x4*)(p_ + 4); } while (0)
            ROPE_LD(0, 0);
#pragma unroll
            for (int i = 0; i < 8; ++i) {
                if (i + 1 < 8) ROPE_LD(i + 1, (i + 1) & 1);
                const int ai = i >> 2, mm = i & 3, row = row0 + ai * HALF + mm * 16;
                const float rs = rsv[i];
                const f32x4 c01 = cs[i & 1][0], c23 = cs[i & 1][1];
#pragma unroll
                for (int bj = 0; bj < 2; ++bj) {
                    const int col = colb + bj * HALF;
                    const f32x4 v0 = acc[ai][bj][mm][0] * rs, v1 = acc[ai][bj][mm][1] * rs;
                    f32x4 o0, o1;
                    o0[0] = v0[0] * c01[0] - v0[1] * c01[1]; o0[1] = v0[1] * c01[0] + v0[0] * c01[1];
                    o0[2] = v0[2] * c01[2] - v0[3] * c01[3]; o0[3] = v0[3] * c01[2] + v0[2] * c01[3];
                    o1[0] = v1[0] * c23[0] - v1[1] * c23[1]; o1[1] = v1[1] * c23[0] + v1[0] * c23[1];
                    o1[2] = v1[2] * c23[2] - v1[3] * c23[3]; o1[3] = v1[3] * c23[2] + v1[2] * c23[3];
                    bf16_t* dst = pn < 4 ? Q + (size_t)row * 1024 + col : K + (size_t)row * 256 + (col - 1024);
                    u32x4 w; w.x = cvt_pk_bf16(o0[0], o0[1]); w.y = cvt_pk_bf16(o0[2], o0[3]); w.z = cvt_pk_bf16(o1[0], o1[1]); w.w = cvt_pk_bf16(o1[2], o1[3]);
                    *(u32x4*)dst = w;
                }
            }
#undef ROPE_LD
        } else {
#pragma unroll
            for (int i = 0; i < 8; ++i) {
                const int ai = i >> 2, mm = i & 3, row = row0 + ai * HALF + mm * 16;
                const float rs = rsv[i];
#pragma unroll
                for (int bj = 0; bj < 2; ++bj) {
                    const int col = colb + bj * HALF;
                    f32x4 v0 = acc[ai][bj][mm][0] * rs, v1 = acc[ai][bj][mm][1] * rs;
                    bf16_t* dst;
                    if (pn == 5) dst = V + (size_t)row * 256 + (col - 1280);
                    else {
#pragma unroll
                        for (int e = 0; e < 4; ++e) { v0[e] = v0[e] * fsigmoid(v0[e]); v1[e] = v1[e] * fsigmoid(v1[e]); }
                        dst = Z + (size_t)row * 1024 + (col - 1536);
                    }
                    u32x4 w; w.x = cvt_pk_bf16(v0[0], v0[1]); w.y = cvt_pk_bf16(v0[2], v0[3]); w.z = cvt_pk_bf16(v1[0], v1[1]); w.w = cvt_pk_bf16(v1[2], v1[3]);
                    *(u32x4*)dst = w;
                }
            }
        }
    }
};
struct EpiMlstmIn {
    static constexpr bool PERM = true, AFTER_DRAIN = false;
    bf16_t *Q, *K, *V, *G; float* gates; const float* bias; const u64_t* ss;
    __device__ __forceinline__ void operator()(const f32x4 (&acc)[2][2][4][2], const Unit& u, int wr, int wc, int fr, int fq) const {
        const int row0 = u.pm * BM + wr * 64 + fr, pn = u.pn;
        float rsv[8];
#pragma unroll
        for (int i = 0; i < 8; ++i) rsv[i] = (float)ss[row0 + (i >> 2) * HALF + (i & 3) * 16];
#pragma unroll
        for (int i = 0; i < 8; ++i) rsv[i] = rsqrtf(rsv[i] * SS_INV + 1e-6f);
        f32x4 bia0 = {0.f, 0.f, 0.f, 0.f}, bia1 = {0.f, 0.f, 0.f, 0.f};
        if (pn == 16 && wc == 0 && fq < 2) { bia0 = *(const f32x4*)(bias + 8 * fq); bia1 = *(const f32x4*)(bias + 8 * fq + 4); }
#pragma unroll
        for (int ai = 0; ai < 2; ++ai)
#pragma unroll
            for (int m = 0; m < 4; ++m) {
                const int row = row0 + ai * HALF + m * 16;
                const float rs = rsv[ai * 4 + m];
#pragma unroll
                for (int bj = 0; bj < 2; ++bj) {
                    const int col = pn * BM + bj * HALF + wc * 32 + 8 * fq;
                    const f32x4 v0 = acc[ai][bj][m][0] * rs, v1 = acc[ai][bj][m][1] * rs;
                    if (pn < 8) {
                        bf16_t* dst = pn < 2 ? Q + (size_t)row * 512 + col : (pn < 4 ? K + (size_t)row * 512 + (col - 512) : V + (size_t)row * 1024 + (col - 1024));
                        u32x4 w; w.x = cvt_pk_bf16(v0[0], v0[1]); w.y = cvt_pk_bf16(v0[2], v0[3]); w.z = cvt_pk_bf16(v1[0], v1[1]); w.w = cvt_pk_bf16(v1[2], v1[3]);
                        *(u32x4*)dst = w;
                    } else if (pn < 16) {
                        const float g0 = v0[1] * __builtin_amdgcn_rcpf((1.f + __expf(-v0[0])) * (1.f + __expf(-v0[1])));
                        const float g1 = v0[3] * __builtin_amdgcn_rcpf((1.f + __expf(-v0[2])) * (1.f + __expf(-v0[3])));
                        const float g2 = v1[1] * __builtin_amdgcn_rcpf((1.f + __expf(-v1[0])) * (1.f + __expf(-v1[1])));
                        const float g3 = v1[3] * __builtin_amdgcn_rcpf((1.f + __expf(-v1[2])) * (1.f + __expf(-v1[3])));
                        u32x2 w; w.x = cvt_pk_bf16(g0, g1); w.y = cvt_pk_bf16(g2, g3);
                        *(u32x2*)(G + (size_t)row * 1024 + ((col - 2048) >> 1)) = w;
                    } else {
                        const int gc = col - 4096;
                        if (gc < 16) {
                            *(f32x4*)(gates + (size_t)row * 16 + gc) = v0 + bia0;
                            *(f32x4*)(gates + (size_t)row * 16 + gc + 4) = v1 + bia1;
                        }
                    }
                }
            }
    }
};
struct EpiResid {
    static constexpr bool PERM = true, AFTER_DRAIN = false;
    const float* in0; const float* in1;
    float* out; bf16_t* xb; u64_t* ss;
    __device__ __forceinline__ void operator()(const f32x4 (&acc)[2][2][4][2], const Unit& u, int wr, int wc, int fr, int fq) const {
        const int row0 = u.pm * BM + wr * 64 + fr;
        const size_t coff = (size_t)u.pn * BM + wc * 32 + 8 * fq;
        f32x4 pre[3][4];
#define RES_LD(i, buf) do { const int row_ = row0 + ((i) >> 2) * HALF + ((i) & 3) * 16; const size_t off_ = (size_t)row_ * 1024 + coff; \
        const float* bp_ = in0 ? (row_ < NPROMPT ? in0 + off_ : in1 + (off_ - (size_t)NPROMPT * 1024)) : out + off_; \
        pre[buf][0] = *(const f32x4*)(bp_); pre[buf][1] = *(const f32x4*)(bp_ + 4); pre[buf][2] = *(const f32x4*)(bp_ + HALF); pre[buf][3] = *(const f32x4*)(bp_ + HALF + 4); } while (0)
        RES_LD(0, 0); RES_LD(1, 1);
#pragma unroll
        for (int i = 0; i < 8; ++i) {
            if (i + 2 < 8) RES_LD(i + 2, (i + 2) % 3);
            const int ai = i >> 2, mm = i & 3, row = row0 + ai * HALF + mm * 16;
            const size_t off = (size_t)row * 1024 + coff;
            float sq = 0.f;
#pragma unroll
            for (int bj = 0; bj < 2; ++bj) {
                const f32x4 x0 = pre[i % 3][2 * bj] + acc[ai][bj][mm][0], x1 = pre[i % 3][2 * bj + 1] + acc[ai][bj][mm][1];
                *(f32x4*)(out + off + bj * HALF) = x0; *(f32x4*)(out + off + bj * HALF + 4) = x1;
                if (ss) {
                    u32x4 w; w.x = cvt_pk_bf16(x0[0], x0[1]); w.y = cvt_pk_bf16(x0[2], x0[3]); w.z = cvt_pk_bf16(x1[0], x1[1]); w.w = cvt_pk_bf16(x1[2], x1[3]);
                    *(u32x4*)(xb + off + bj * HALF) = w;
                    sq += x0[0] * x0[0] + x0[1] * x0[1] + x0[2] * x0[2] + x0[3] * x0[3] + x1[0] * x1[0] + x1[1] * x1[1] + x1[2] * x1[2] + x1[3] * x1[3];
                }
            }
            if (ss) {
                sq += __shfl_xor(sq, 16); sq += __shfl_xor(sq, 32);
                if (fq == 0) atomicAdd(ss + row, (u64_t)(sq * SS_SCALE + 0.5f));
            }
        }
#undef RES_LD
    }
};
}

__device__ __forceinline__ void prep_phase(const Args& a, ldsp lds, int G) {
    const int tid = opaque_tid();
    LAS float* tile = (LAS float*)lds;
    for (int it = opaque_bid(); it < 4480; it += G) {
        const int j = it / 2240; int r = it % 2240; int wt;
        if (r < 640) wt = 0; else if (r < 896) { wt = 1; r -= 640; } else if (r < 1984) { wt = 2; r -= 896; } else { wt = 3; r -= 1984; }
        const int nt = r >> 4, kt = r & 15;
        const float* W; int Nsrc; const float* g = nullptr; bf16_t* dst;
        if (wt == 0) { W = a.in[3] + (size_t)j * 1024 * 2560; Nsrc = 2560; g = a.in[2] + (2 * j) * 1024; dst = (bf16_t*)(a.ws + WS_WA + j * WA_SZ); }
        else if (wt == 1) { W = a.in[5] + (size_t)j * 1024 * 1024; Nsrc = 1024; dst = (bf16_t*)(a.ws + WS_WAO + j * WO_SZ); }
        else if (wt == 2) { W = a.in[6] + (size_t)j * 1024 * 4112; Nsrc = 4112; g = a.in[2] + (2 * j + 1) * 1024; dst = (bf16_t*)(a.ws + WS_WM + j * WM_SZ); }
        else { W = a.in[9] + (size_t)j * 1024 * 1024; Nsrc = 1024; dst = (bf16_t*)(a.ws + WS_WMO + j * WO_SZ); }
        const int nn = tid & 63, np = nt * 64 + nn;
        int src = np; float sc = 1.f;
        if (wt == 0) {
            if (np < 1280) { const int base = np < 1024 ? 0 : 1024, m = np - base; src = base + (m & ~63) + ((m & 63) >> 1) + 32 * (m & 1); if (np < 1024) sc = 0.125f * LOG2E; }
        } else if (wt == 2) {
            if (np < 2048) { if (np >= 512 && np < 1024) sc = 0.08838834764831845f; }
            else if (np < 4096) { const int jj = np - 2048; src = (jj & 1) ? 3072 + (jj >> 1) : 2048 + (jj >> 1); }
            else if (np >= 4112) src = -1;
        }
#pragma unroll
        for (int p = 0; p < 8; ++p) {
            const int kk = p * 8 + (tid >> 6), k = kt * 64 + kk; float v = 0.f;
            if (src >= 0) { v = W[(size_t)k * Nsrc + src] * sc; if (g) v *= g[k]; }
            tile[kk * 65 + nn] = v;
        }
        __syncthreads();
        {
            const int n2 = tid >> 3, kc = tid & 7;
            const float v0 = tile[(kc * 8 + 0) * 65 + n2], v1 = tile[(kc * 8 + 1) * 65 + n2], v2 = tile[(kc * 8 + 2) * 65 + n2], v3 = tile[(kc * 8 + 3) * 65 + n2];
            const float v4 = tile[(kc * 8 + 4) * 65 + n2], v5 = tile[(kc * 8 + 5) * 65 + n2], v6 = tile[(kc * 8 + 6) * 65 + n2], v7 = tile[(kc * 8 + 7) * 65 + n2];
            u32x4 w; w.x = pk2(v0, v1); w.y = pk2(v2, v3); w.z = pk2(v4, v5); w.w = pk2(v6, v7);
            *(u32x4*)(dst + (size_t)(nt * 64 + n2) * 1024 + kt * 64 + kc * 8) = w;
        }
        __syncthreads();
    }
    float* rope = (float*)(a.ws + WS_ROPE);
    for (int idx = opaque_bid() * 512 + tid; idx < 16384 * 32; idx += G * 512) {
        const int pos = idx >> 5, i = idx & 31;
        const float inv = expf((-9.210340371976184f * (float)i) / 32.0f);
        const float ang = (float)pos * inv;
        double rev = (double)ang * 0.15915494309189535; rev -= floor(rev);
        const float fr = (float)rev;
        rope[2 * idx] = __builtin_amdgcn_cosf(fr); rope[2 * idx + 1] = __builtin_amdgcn_sinf(fr);
    }
}

__device__ __forceinline__ void norm_phase(const Args& a, int mode, int G) {
    const int tid_ = opaque_tid(); const int lane = tid_ & 63, wave = tid_ >> 6;
    bf16_t* xb = (bf16_t*)(a.ws + WS_R0);
    u64_t* ss0 = (u64_t*)(a.ws + WS_SS);
    if (mode == 0) { for (int i = opaque_bid() * 512 + tid_; i < 3 * MTOK; i += G * 512) ss0[MTOK + i] = 0ull; }
    for (int row = opaque_bid() * 8 + wave; row < MTOK; row += G * 8) {
        const float* src = mode == 0 ? (row < NPROMPT ? a.in[0] + (size_t)row * DM : a.in[1] + (size_t)(row - NPROMPT) * DM) : a.out + (size_t)row * DM;
        const f32x4 v0 = __builtin_nontemporal_load((const f32x4*)src + lane), v1 = __builtin_nontemporal_load((const f32x4*)src + lane + 64), v2 = __builtin_nontemporal_load((const f32x4*)src + lane + 128), v3 = __builtin_nontemporal_load((const f32x4*)src + lane + 192);
        float ss = v0[0] * v0[0] + v0[1] * v0[1] + v0[2] * v0[2] + v0[3] * v0[3] + v1[0] * v1[0] + v1[1] * v1[1] + v1[2] * v1[2] + v1[3] * v1[3]
                 + v2[0] * v2[0] + v2[1] * v2[1] + v2[2] * v2[2] + v2[3] * v2[3] + v3[0] * v3[0] + v3[1] * v3[1] + v3[2] * v3[2] + v3[3] * v3[3];
#pragma unroll
        for (int o = 32; o >= 1; o >>= 1) ss += __shfl_xor(ss, o);
        if (mode == 2) {
            const float rs = rsqrtf(ss * (1.f / 1024.f) + 1e-6f);
            const f32x4* g = (const f32x4*)a.in[10];
            f32x4* o = (f32x4*)(a.out + (size_t)row * DM);
            __builtin_nontemporal_store(v0 * rs * g[lane], o + lane); __builtin_nontemporal_store(v1 * rs * g[lane + 64], o + lane + 64); __builtin_nontemporal_store(v2 * rs * g[lane + 128], o + lane + 128); __builtin_nontemporal_store(v3 * rs * g[lane + 192], o + lane + 192);
        } else {
            u32x2* o = (u32x2*)(xb + (size_t)row * DM);
            u32x2 w;
            w.x = pk2(v0[0], v0[1]); w.y = pk2(v0[2], v0[3]); o[lane] = w;
            w.x = pk2(v1[0], v1[1]); w.y = pk2(v1[2], v1[3]); o[lane + 64] = w;
            w.x = pk2(v2[0], v2[1]); w.y = pk2(v2[2], v2[3]); o[lane + 128] = w;
            w.x = pk2(v3[0], v3[1]); w.y = pk2(v3[2], v3[3]); o[lane + 192] = w;
            if (lane == 0) ss0[row] = (u64_t)(ss * SS_SCALE + 0.5f);
        }
    }
}

constexpr int KRS = 144;
__device__ __forceinline__ void attn_phase(const Args& a, ldsp lds, int j, int G) {
    const int tid = opaque_tid(), lane = tid & 63, wave = tid >> 6, l31 = lane & 31, h = lane >> 5;
    const int blk = (lane >> 4) & 1, qsub = (lane & 15) >> 2, p4 = lane & 3;
    const bf16_t* Q = (const bf16_t*)(a.ws + WS_R0 + 1 * RSZ);
    const bf16_t* K = (const bf16_t*)(a.ws + WS_R0 + 2 * RSZ);
    const bf16_t* V = (const bf16_t*)(a.ws + WS_R0 + 2 * RSZ + 48 * MiB);
    const bf16_t* Z = (const bf16_t*)(a.ws + WS_R0 + 3 * RSZ);
    bf16_t* O = (bf16_t*)(a.ws + WS_R0 + 4 * RSZ);
    const float* sink = a.in[4] + j * 16;
    ldsp Ks = lds, Vs = lds + 384 * KRS;
    for (int u = opaque_bid(); u < 3072; u += G) {
        const int g = u & 3, qb = u >> 2, q0 = qb * 128;
        int ss, se;
        if (q0 < NPROMPT) { ss = q0 & ~(SEQ_P - 1); se = ss + SEQ_P; } else { ss = q0 & ~(SEQ_S - 1); se = ss + SEQ_S; }
        const int r = wave >> 1, qtA = 2 * (wave & 1), head = 4 * g + r, r0 = q0 + 32 * qtA;
        const bf16_t* qpa = Q + (size_t)(r0 + l31) * 1024 + head * 64 + 8 * h;
        const bf16_t* qpb = qpa + 32 * 1024;
        const bf16x8 QA0 = *(const bf16x8*)(qpa), QA1 = *(const bf16x8*)(qpa + 16), QA2 = *(const bf16x8*)(qpa + 32), QA3 = *(const bf16x8*)(qpa + 48);
        const bf16x8 QB0 = *(const bf16x8*)(qpb), QB1 = *(const bf16x8*)(qpb + 16), QB2 = *(const bf16x8*)(qpb + 32), QB3 = *(const bf16x8*)(qpb + 48);
        __syncthreads();
#pragma unroll
        for (int i = 0; i < 6; ++i) {
            const int c = tid + 512 * i, r = c >> 3, ch = c & 7, grow = q0 - 128 + r;
            u32x4 kv = {0u, 0u, 0u, 0u}, vv = {0u, 0u, 0u, 0u};
            if (grow >= ss && grow < se) { kv = *(const u32x4*)(K + (size_t)grow * 256 + g * 64 + ch * 8); vv = *(const u32x4*)(V + (size_t)grow * 256 + g * 64 + ch * 8); }
            *(LAS u32x4*)(Ks + r * KRS + ch * 16) = kv; *(LAS u32x4*)(Vs + r * KRS + ch * 16) = vv;
        }
        __syncthreads();
        {
            const float m0 = sink[head] * LOG2E;
            float mA = m0, mB = m0, lA = h == 0 ? 1.f : 0.f, lB = lA;
            f32x16 OA0, OA1, OB0, OB1;
#pragma unroll
            for (int i = 0; i < 16; ++i) { OA0[i] = 0.f; OA1[i] = 0.f; OB0[i] = 0.f; OB1[i] = 0.f; }
            for (int kt = 0; kt < 10; ++kt) {
                const int kb = 32 * qtA + 32 * kt, kg = q0 - 128 + kb;
                if (kg < ss || kg >= se) continue;
                ldsp kp = Ks + (kb + l31) * KRS + 16 * h;
                const bf16x8 K0 = *(const LAS bf16x8*)(kp), K1 = *(const LAS bf16x8*)(kp + 32), K2 = *(const LAS bf16x8*)(kp + 64), K3 = *(const LAS bf16x8*)(kp + 96);
                ldsp vb = Vs + (kb + 4 * h + qsub) * KRS + (16 * blk + 4 * p4) * 2;
                const bf16x8 V00 = cat8(lds_tr(vb), lds_tr(vb + 8 * KRS)), V01 = cat8(lds_tr(vb + 64), lds_tr(vb + 8 * KRS + 64));
                const bf16x8 V10 = cat8(lds_tr(vb + 16 * KRS), lds_tr(vb + 24 * KRS)), V11 = cat8(lds_tr(vb + 16 * KRS + 64), lds_tr(vb + 24 * KRS + 64));
#define ATT_JOB(QQ0, QQ1, QQ2, QQ3, MM, LL, OO0, OO1, KTJ) do { \
                    f32x16 s; \
                    _Pragma("unroll") for (int i = 0; i < 16; ++i) s[i] = 0.f; \
                    s = MFMA32(K0, QQ0, s); s = MFMA32(K1, QQ1, s); s = MFMA32(K2, QQ2, s); s = MFMA32(K3, QQ3, s); \
                    if ((KTJ) == 0 || (KTJ) == 8) { \
                        _Pragma("unroll") for (int i = 0; i < 16; ++i) { const int kk = (i & 3) + 8 * (i >> 2) + 4 * h; \
                            const bool valid = (KTJ) == 0 ? (kk >= l31) : (kk <= l31); if (!valid) s[i] = -INFINITY; } } \
                    float mx = s[0]; \
                    _Pragma("unroll") for (int i = 1; i < 16; ++i) mx = fmaxf(mx, s[i]); \
                    mx = fmaxf(mx, __shfl_xor(mx, 32)); \
                    if (__any(mx > MM + 8.f)) {            \
                        const float mn = fmaxf(MM, mx), alpha = __builtin_amdgcn_exp2f(MM - mn); MM = mn; LL *= alpha; \
                        _Pragma("unroll") for (int i = 0; i < 16; ++i) { OO0[i] *= alpha; OO1[i] *= alpha; } } \
                    float ps = 0.f; \
                    _Pragma("unroll") for (int i = 0; i < 16; ++i) { s[i] = __builtin_amdgcn_exp2f(s[i] - MM); ps += s[i]; } \
                    LL += ps; \
                    const bf16x8 P0 = pack8(s[0], s[1], s[2], s[3], s[4], s[5], s[6], s[7]); \
                    const bf16x8 P1 = pack8(s[8], s[9], s[10], s[11], s[12], s[13], s[14], s[15]); \
                    OO0 = MFMA32(V00, P0, OO0); OO1 = MFMA32(V01, P0, OO1); OO0 = MFMA32(V10, P1, OO0); OO1 = MFMA32(V11, P1, OO1); } while (0)
                if (kt < 9) ATT_JOB(QA0, QA1, QA2, QA3, mA, lA, OA0, OA1, kt);
                if (kt > 0) ATT_JOB(QB0, QB1, QB2, QB3, mB, lB, OB0, OB1, kt - 1);
#undef ATT_JOB
            }
#define ATT_OUT(LL, OO0, OO1, ROWOFF) do { \
                LL += __shfl_xor(LL, 32); \
                const float inv = 1.f / LL; \
                const size_t orow = (size_t)(r0 + (ROWOFF) + l31) * 1024 + head * 64; \
                _Pragma("unroll") for (int gq = 0; gq < 4; ++gq) { \
                    const int d0 = 8 * gq + 4 * h; \
                    const u32x2 z0 = *(const u32x2*)(Z + orow + d0), z1 = *(const u32x2*)(Z + orow + 32 + d0); \
                    u32x2 w; \
                    w.x = pk2(OO0[4 * gq] * inv * bf_lo(z0.x), OO0[4 * gq + 1] * inv * bf_hi(z0.x)); w.y = pk2(OO0[4 * gq + 2] * inv * bf_lo(z0.y), OO0[4 * gq + 3] * inv * bf_hi(z0.y)); \
                    *(u32x2*)(O + orow + d0) = w; \
                    w.x = pk2(OO1[4 * gq] * inv * bf_lo(z1.x), OO1[4 * gq + 1] * inv * bf_hi(z1.x)); w.y = pk2(OO1[4 * gq + 2] * inv * bf_lo(z1.y), OO1[4 * gq + 3] * inv * bf_hi(z1.y)); \
                    *(u32x2*)(O + orow + 32 + d0) = w; } } while (0)
            ATT_OUT(lA, OA0, OA1, 0);
            ATT_OUT(lB, OB0, OB1, 32);
#undef ATT_OUT
        }
    }
}

constexpr int GV_STRIDE = 208;
__device__ __forceinline__ void gatescan_phase(const Args& a, int G) {
    const int tid_ = opaque_tid(); const int lane = tid_ & 63, wave = tid_ >> 6;
    const float* gates = (const float*)(a.ws + WS_GATES);
    float* GV = (float*)(a.ws + WS_GV);
    for (int task = opaque_bid() * 8 + wave; task < 1536 * 8; task += G * 8) {
        const int cgl = task >> 3, dh = task & 7, dir = dh >> 2, head = dh & 3;
        const int jx = dir ? 63 - lane : lane;
        const float* gp = gates + ((size_t)cgl * 64 + jx) * 16 + dir * 8 + head;
        const float gi = gp[0], gf = gp[4];
        float x = fminf(gf, 0.f) - log1pf(expf(-fabsf(gf)));
#pragma unroll
        for (int d = 1; d < 64; d <<= 1) { const float t = __shfl_up(x, d); if (lane >= d) x += t; }
        const float aa = gi - x; float pmx = aa;
#pragma unroll
        for (int d = 1; d < 64; d <<= 1) { const float t = __shfl_up(pmx, d); if (lane >= d) pmx = fmaxf(pmx, t); }
        float* o = GV + (size_t)task * GV_STRIDE;
        const float pm_all = __shfl(pmx, 63);
        o[jx] = x; o[64 + jx] = __expf(aa - pm_all); o[128 + jx] = pmx;
        if (lane == 63) { o[192] = x; o[193] = pmx; }
    }
}

constexpr int QRS = 272, VRS = 144;
constexpr int ML_XB = 141952, ML_XP = ML_XB, ML_XQ = ML_XB + 9216, ML_XS = ML_XQ + 8192, ML_XF = ML_XS + 1024;
constexpr int ML_Q = 0, ML_K = 34816, ML_V = 69632, ML_C = 88064, ML_CSZ = 26112  , ML_GB = 140288, ML_GBSZ = 832;
__device__ __forceinline__ void hn_phase(const Args& a, int j, int row_lo, int row_hi, int bidx, int nblk);
__device__ __forceinline__ void mlstm_phase(const Args& a, ldsp lds, int j, int G) {
    const int tid = opaque_tid(), lane = tid & 63, wave = __builtin_amdgcn_readfirstlane(tid >> 6), l31 = lane & 31, h = lane >> 5;
    const int blk = (lane >> 4) & 1, qsub = (lane & 15) >> 2, p4 = lane & 3;
    const bf16_t* Qg = (const bf16_t*)(a.ws + WS_R0 + 1 * RSZ);
    const bf16_t* Kg = (const bf16_t*)(a.ws + WS_R0 + 1 * RSZ + 96 * MiB);
    const bf16_t* Vg = (const bf16_t*)(a.ws + WS_R0 + 2 * RSZ);
    const float* GV = (const float*)(a.ws + WS_GV);
    int first, stride;
    if (G >= 128) {
        first = opaque_bid(); stride = first < 64 ? (1 << 28) : G - 64;
        if (first >= 64 && ((G - 64) & 31) == 0) { const int xcd = first & 7, idx = (first - 64) >> 3, per = (G - 64) >> 3; first = 64 + xcd * per + idx; }
        else if (first < 64) first = (first & 7) * 8 + (first >> 3);
    } else { first = opaque_bid(); stride = G; }
#define ML_LD1(k, dq, dk) do { const unsigned o_ = (unsigned)(((tid2 + 256 * (k)) >> 4) * 512 + ((tid2 + 256 * (k)) & 15) * 8); dq = *(const u32x4*)(qu_ + o_); dk = *(const u32x4*)(ku_ + o_); } while (0)
#define ML_ST1(k, dq, dk) do { const int c = tid2 + 256 * (k), r = c >> 4, ch = c & 15; *(LAS u32x4*)(Qw + r * QRS + ch * 16) = dq; *(LAS u32x4*)(Kw + r * QRS + ch * 16) = dk; } while (0)
#define ML_LOAD(chunk) do { const size_t tok0 = base + (size_t)(chunk) * 64;     \
            const bf16_t* qu_ = Qg + tok0 * 512 + head * 128; const bf16_t* ku_ = Kg + tok0 * 512 + head * 128; const bf16_t* vu_ = Vg + tok0 * 1024 + head * 256 + sl * 64; \
            ML_LD1(0, rq0, rk0); ML_LD1(1, rq1, rk1); ML_LD1(2, rq2, rk2); ML_LD1(3, rq3, rk3); \
            { const unsigned o_ = (unsigned)((tid2 >> 3) * 1024 + (tid2 & 7) * 8); pv0 = *(const u32x4*)(vu_ + o_); pv1 = *(const u32x4*)(vu_ + (o_ + 32u * 1024u)); } \
            if (tid2 < 52) pg = *(const f32x4*)(gvb + (size_t)(chunk) * (8 * GV_STRIDE) + (unsigned)(tid2 * 4)); } while (0)
#define ML_STORE(par) do { ldsp Qw = lds + ML_Q + (par) * 17408, Kw = lds + ML_K + (par) * 17408, Vw = lds + ML_V + (par) * 9216; \
            ML_ST1(0, rq0, rk0); ML_ST1(1, rq1, rk1); ML_ST1(2, rq2, rk2); ML_ST1(3, rq3, rk3); \
            { const int r = tid2 >> 3, ch = tid2 & 7; *(LAS u32x4*)(Vw + r * VRS + ch * 16) = pv0; *(LAS u32x4*)(Vw + (32 + r) * VRS + ch * 16) = pv1; } \
            if (tid2 < 52) *(LAS f32x4*)(lds + ML_GB + (par) * ML_GBSZ + tid2 * 16) = pg; } while (0)
    for (int it = first; it < 1088; it += stride) {
        int seq, NC; size_t base; int t2 = it;
        if (it < 64) { NC = 256; seq = it >> 5; base = (size_t)seq * SEQ_P; } else { t2 = it - 64; NC = 32; seq = t2 >> 5; base = (size_t)NPROMPT + (size_t)seq * SEQ_S; }
        const int head = (t2 >> 3) & 3, dir = (t2 >> 2) & 1, sl = t2 & 3;
        bf16_t* Hout = (bf16_t*)(a.ws + WS_R0 + (dir ? 4 * RSZ : 0));
        __syncthreads();
        for (int i = tid; i < 2 * ML_CSZ / 16; i += 512) *(LAS u32x4*)(lds + ML_C + i * 16) = (u32x4){0u, 0u, 0u, 0u};
        if (tid < 16) ((LAS unsigned*)(lds + ML_XF))[tid] = 0u;
        const float* gvb = GV + ((base >> 6) * 8 + dir * 4 + head) * GV_STRIDE;
        if (wave < 4) {
            const int vt = wave & 1, tt = wave >> 1, t = 32 * tt + l31;
            float mc = -1e30f;
            ldsp XP = lds + ML_XP + tt * 4608, XQ = lds + ML_XQ + tt * 4096;
            LAS float* XS = (LAS float*)(lds + ML_XS + tt * 512);
            volatile LAS unsigned* flagP = (volatile LAS unsigned*)(lds + ML_XF) + tt;
            volatile LAS unsigned* flagQ = (volatile LAS unsigned*)(lds + ML_XF) + 2 + tt;
            for (int i = 0; i < NC; ++i) {
                const int chunk = dir ? NC - 1 - i : i, par = i & 1;
                __syncthreads();
                ldsp Qs = lds + ML_Q + par * 17408, Ks = lds + ML_K + par * 17408, Vs = lds + ML_V + par * 9216, Cs = lds + ML_C + par * ML_CSZ;
                LAS const float* gb = (LAS const float*)(lds + ML_GB + par * ML_GBSZ);
                const float b_end = gb[192], pm_all = gb[193];
                const float pm_t = gb[128 + t], b_t = gb[t];
                const float mx = fmaxf(pm_t, mc), ft = __expf(pm_all - mx), sc = __expf(mc - mx), em = __expf(-(b_t + mx));
                bf16x8 Qf[8];
#pragma unroll
                for (int ks = 0; ks < 8; ++ks) Qf[ks] = *(const LAS bf16x8*)(Qs + t * QRS + (16 * ks + 8 * h) * 2);
                f32x16 acc;
#pragma unroll
                for (int q = 0; q < 16; ++q) acc[q] = 0.f;
                float rstot, qn;
                f32x16 acc2;
                if (dir == 0 ? (tt == 1) : (tt == 0)) {
                    volatile LAS unsigned* fMine = (volatile LAS unsigned*)(lds + ML_XF) + 4 + 2 * tt + vt;
                    volatile LAS unsigned* fPart = (volatile LAS unsigned*)(lds + ML_XF) + 4 + 2 * tt + (vt ^ 1);
                    volatile LAS unsigned* fN = (volatile LAS unsigned*)(lds + ML_XF) + 8 + tt;
                    const int st = vt, st2 = vt ^ 1;
                    float rowsum = 0.f;
                    f32x16 s;
#pragma unroll
                    for (int q = 0; q < 16; ++q) { s[q] = 0.f; acc2[q] = 0.f; }
#pragma unroll
                    for (int ks = 0; ks < 8; ++ks) s = MFMA32(*(const LAS bf16x8*)(Ks + (32 * st + l31) * QRS + (16 * ks + 8 * h) * 2), Qf[ks], s);
#pragma unroll
                    for (int gq = 0; gq < 4; ++gq) {
                        const f32x4 av = *(LAS const f32x4*)(gb + 64 + 32 * st + 8 * gq + 4 * h);
#pragma unroll
                        for (int e = 0; e < 4; ++e) {
                            const int sidx = 32 * st + 8 * gq + 4 * h + e;
                            const bool valid = (st != tt) || (dir == 0 ? (sidx <= t) : (sidx >= t));
                            const float p = valid ? av[e] * s[4 * gq + e] : 0.f;
                            s[4 * gq + e] = p; rowsum += p;
                        }
                    }
                    const bf16x8 P0 = pack8(s[0], s[1], s[2], s[3], s[4], s[5], s[6], s[7]);
                    const bf16x8 P1 = pack8(s[8], s[9], s[10], s[11], s[12], s[13], s[14], s[15]);
                    {
                        const u32x4 w0 = __builtin_bit_cast(u32x4, P0), w1 = __builtin_bit_cast(u32x4, P1);
                        ldsp pp = XP + l31 * 144 + (32 * st + 4 * h) * 2;
                        *(LAS u32x2*)(pp) = (u32x2){w0.x, w0.y}; *(LAS u32x2*)(pp + 16) = (u32x2){w0.z, w0.w};
                        *(LAS u32x2*)(pp + 32) = (u32x2){w1.x, w1.y}; *(LAS u32x2*)(pp + 48) = (u32x2){w1.z, w1.w};
                    }
                    const float rs_own = rowsum + __shfl_xor(rowsum, 32);
                    if (h == 0) XS[64 * vt + l31] = rs_own;
                    asm volatile("s_waitcnt lgkmcnt(0)" ::: "memory");
                    if (lane == 0) *fMine = (unsigned)(i + 1);
                    {
                        ldsp vb = Vs + (32 * st + 4 * h + qsub) * VRS + (32 * vt + 16 * blk + 4 * p4) * 2;
                        acc = MFMA32(cat8(lds_tr(vb), lds_tr(vb + 8 * VRS)), P0, acc);
                        acc = MFMA32(cat8(lds_tr(vb + 16 * VRS), lds_tr(vb + 24 * VRS)), P1, acc);
                    }
#pragma unroll
                    for (int ks = 0; ks < 8; ++ks) acc2 = MFMA32(*(const LAS bf16x8*)(Cs + (32 * vt + l31) * QRS + (16 * ks + 8 * h) * 2), Qf[ks], acc2);
                    qn = 0.f;
                    if (vt == 0) {
                        f32x16 acc3;
#pragma unroll
                        for (int q = 0; q < 16; ++q) acc3[q] = 0.f;
#pragma unroll
                        for (int ks = 0; ks < 8; ++ks) acc3 = MFMA32(*(const LAS bf16x8*)(Cs + (64 + l31) * QRS + (16 * ks + 8 * h) * 2), Qf[ks], acc3);
                        if (h == 0) XS[32 + l31] = acc3[0];
                        asm volatile("s_waitcnt lgkmcnt(0)" ::: "memory");
                        if (lane == 0) *fN = (unsigned)(i + 1);
                        qn = __shfl(acc3[0], l31);
                    }
                    while (*fPart != (unsigned)(i + 1)) __builtin_amdgcn_s_sleep(1);
                    asm volatile("s_waitcnt lgkmcnt(0)" ::: "memory");
#pragma unroll
                    for (int s2 = 0; s2 < 2; ++s2) {
                        const bf16x8 Pf = *(const LAS bf16x8*)(XP + l31 * 144 + (32 * st2 + 16 * s2 + 8 * h) * 2);
                        ldsp vb2 = Vs + (32 * st2 + 16 * s2 + 8 * h + qsub) * VRS + (32 * vt + 16 * blk + 4 * p4) * 2;
                        acc = MFMA32(cat8(lds_tr(vb2), lds_tr(vb2 + 4 * VRS)), Pf, acc);
                    }
                    rstot = rs_own + XS[64 * (vt ^ 1) + l31];
                    if (vt == 1) {
                        while (*fN != (unsigned)(i + 1)) __builtin_amdgcn_s_sleep(1);
                        asm volatile("s_waitcnt lgkmcnt(0)" ::: "memory");
                        qn = XS[32 + l31];
                    }
                } else if (vt == 0) {
                    float rowsum = 0.f;
#pragma unroll
                    for (int st = 0; st < 2; ++st) {
                        if (dir == 0 ? (st > tt) : (st < tt)) continue;
                        f32x16 s;
#pragma unroll
                        for (int q = 0; q < 16; ++q) s[q] = 0.f;
#pragma unroll
                        for (int ks = 0; ks < 8; ++ks) s = MFMA32(*(const LAS bf16x8*)(Ks + (32 * st + l31) * QRS + (16 * ks + 8 * h) * 2), Qf[ks], s);
#pragma unroll
                        for (int gq = 0; gq < 4; ++gq) {
                            const f32x4 av = *(LAS const f32x4*)(gb + 64 + 32 * st + 8 * gq + 4 * h);
#pragma unroll
                            for (int e = 0; e < 4; ++e) {
                                const int sidx = 32 * st + 8 * gq + 4 * h + e;
                                const bool valid = (st != tt) || (dir == 0 ? (sidx <= t) : (sidx >= t));
                                const float p = valid ? av[e] * s[4 * gq + e] : 0.f;
                                s[4 * gq + e] = p; rowsum += p;
                            }
                        }
                        const bf16x8 P0 = pack8(s[0], s[1], s[2], s[3], s[4], s[5], s[6], s[7]);
                        const bf16x8 P1 = pack8(s[8], s[9], s[10], s[11], s[12], s[13], s[14], s[15]);
                        {
                            const u32x4 w0 = __builtin_bit_cast(u32x4, P0), w1 = __builtin_bit_cast(u32x4, P1);
                            ldsp pp = XP + l31 * 144 + (32 * st + 4 * h) * 2;
                            *(LAS u32x2*)(pp) = (u32x2){w0.x, w0.y}; *(LAS u32x2*)(pp + 16) = (u32x2){w0.z, w0.w};
                            *(LAS u32x2*)(pp + 32) = (u32x2){w1.x, w1.y}; *(LAS u32x2*)(pp + 48) = (u32x2){w1.z, w1.w};
                        }
                        ldsp vb = Vs + (32 * st + 4 * h + qsub) * VRS + (16 * blk + 4 * p4) * 2;
                        acc = MFMA32(cat8(lds_tr(vb), lds_tr(vb + 8 * VRS)), P0, acc);
                        acc = MFMA32(cat8(lds_tr(vb + 16 * VRS), lds_tr(vb + 24 * VRS)), P1, acc);
                    }
                    rstot = rowsum + __shfl_xor(rowsum, 32);
                    if (h == 0) XS[l31] = rstot;
                    asm volatile("s_waitcnt lgkmcnt(0)" ::: "memory");
                    if (lane == 0) *flagP = (unsigned)(i + 1);
                    while (*flagQ != (unsigned)(i + 1)) __builtin_amdgcn_s_sleep(1);
                    asm volatile("s_waitcnt lgkmcnt(0)" ::: "memory");
#pragma unroll
                    for (int g4 = 0; g4 < 4; ++g4) { const f32x4 x = *(LAS const f32x4*)(XQ + (g4 * 64 + lane) * 16); acc2[4 * g4] = x[0]; acc2[4 * g4 + 1] = x[1]; acc2[4 * g4 + 2] = x[2]; acc2[4 * g4 + 3] = x[3]; }
                    qn = XS[32 + l31];
                } else {
                    f32x16 accA, acc3;
#pragma unroll
                    for (int q = 0; q < 16; ++q) { accA[q] = 0.f; acc2[q] = 0.f; acc3[q] = 0.f; }
#pragma unroll
                    for (int ks = 0; ks < 8; ++ks) accA = MFMA32(*(const LAS bf16x8*)(Cs + l31 * QRS + (16 * ks + 8 * h) * 2), Qf[ks], accA);
#pragma unroll
                    for (int ks = 0; ks < 8; ++ks) acc3 = MFMA32(*(const LAS bf16x8*)(Cs + (64 + l31) * QRS + (16 * ks + 8 * h) * 2), Qf[ks], acc3);
#pragma unroll
                    for (int g4 = 0; g4 < 4; ++g4) *(LAS f32x4*)(XQ + (g4 * 64 + lane) * 16) = (f32x4){accA[4 * g4], accA[4 * g4 + 1], accA[4 * g4 + 2], accA[4 * g4 + 3]};
                    if (h == 0) XS[32 + l31] = acc3[0];
                    asm volatile("s_waitcnt lgkmcnt(0)" ::: "memory");
                    if (lane == 0) *flagQ = (unsigned)(i + 1);
#pragma unroll
                    for (int ks = 0; ks < 8; ++ks) acc2 = MFMA32(*(const LAS bf16x8*)(Cs + (32 + l31) * QRS + (16 * ks + 8 * h) * 2), Qf[ks], acc2);
                    qn = __shfl(acc3[0], l31);
                    while (*flagP != (unsigned)(i + 1)) __builtin_amdgcn_s_sleep(1);
                    asm volatile("s_waitcnt lgkmcnt(0)" ::: "memory");
#pragma unroll
                    for (int st = 0; st < 2; ++st) {
                        if (dir == 0 ? (st > tt) : (st < tt)) continue;
#pragma unroll
                        for (int s2 = 0; s2 < 2; ++s2) {
                            const bf16x8 Pf = *(const LAS bf16x8*)(XP + l31 * 144 + (32 * st + 16 * s2 + 8 * h) * 2);
                            ldsp vb2 = Vs + (32 * st + 16 * s2 + 8 * h + qsub) * VRS + (32 + 16 * blk + 4 * p4) * 2;
                            acc = MFMA32(cat8(lds_tr(vb2), lds_tr(vb2 + 4 * VRS)), Pf, acc);
                        }
                    }
                    rstot = XS[l31];
                }
#pragma unroll
                for (int q = 0; q < 16; ++q) acc[q] = ft * acc[q] + sc * acc2[q];
                const float den = ft * rstot + sc * qn;
                const float inv = 1.f / fmaxf(fabsf(den), em);
                bf16_t* hp = (Hout + (base + (size_t)chunk * 64) * 1024 + head * 256 + sl * 64) + (unsigned)(t * 1024 + 32 * vt + 4 * h);
#pragma unroll
                for (int gq = 0; gq < 4; ++gq) {
                    u32x2 w; w.x = pk2(acc[4 * gq] * inv, acc[4 * gq + 1] * inv); w.y = pk2(acc[4 * gq + 2] * inv, acc[4 * gq + 3] * inv);
                    *(u32x2*)(hp + 8 * gq) = w;
                }
                mc = b_end + fmaxf(mc, pm_all);
            }
        } else {
            const int w2 = wave - 4, tid2 = tid - 256;
            float mc = -1e30f;
            f32x16 c0, c1, nacc;
#pragma unroll
            for (int i = 0; i < 16; ++i) { c0[i] = 0.f; c1[i] = 0.f; nacc[i] = 0.f; }
            u32x4 rq0, rq1, rq2, rq3, rk0, rk1, rk2, rk3, pv0, pv1; f32x4 pg = {0.f, 0.f, 0.f, 0.f};
            ML_LOAD(dir ? NC - 1 : 0);
            ML_STORE(0);
            ML_LOAD(dir ? NC - 2 : 1);
            for (int i = 0; i < NC; ++i) {
                const int par = i & 1;
                __syncthreads();
                if (i + 1 < NC) ML_STORE(par ^ 1);
                if (i + 2 < NC) ML_LOAD(dir ? NC - 3 - i : i + 2);
                ldsp Qs = lds + ML_Q + par * 17408, Ks = lds + ML_K + par * 17408, Vs = lds + ML_V + par * 9216;
                LAS const float* gb = (LAS const float*)(lds + ML_GB + par * ML_GBSZ);
                const float b_end = gb[192], pm_all = gb[193];
                const float mxa = fmaxf(mc, pm_all), sp = __expf(mc - mxa), su = __expf(pm_all - mxa);
#pragma unroll
                for (int q = 0; q < 16; ++q) { c0[q] *= sp; c1[q] *= sp; nacc[q] *= sp; }
                const bf16x8 ONES = {(short)0x3F80, (short)0x3F80, (short)0x3F80, (short)0x3F80, (short)0x3F80, (short)0x3F80, (short)0x3F80, (short)0x3F80};
#pragma unroll
                for (int s2 = 0; s2 < 4; ++s2) {
                    ldsp kb2 = Ks + (16 * s2 + 8 * h + qsub) * QRS + (32 * w2 + 16 * blk + 4 * p4) * 2;
                    const s16x4 klo = lds_tr(kb2), khi = lds_tr(kb2 + 4 * QRS);
                    const f32x4 a0 = *(LAS const f32x4*)(gb + 64 + 16 * s2 + 8 * h), a1 = *(LAS const f32x4*)(gb + 64 + 16 * s2 + 8 * h + 4);
                    const bf16x8 Au = pack8(bf_s(klo[0]) * (a0[0] * su), bf_s(klo[1]) * (a0[1] * su), bf_s(klo[2]) * (a0[2] * su), bf_s(klo[3]) * (a0[3] * su),
                                            bf_s(khi[0]) * (a1[0] * su), bf_s(khi[1]) * (a1[1] * su), bf_s(khi[2]) * (a1[2] * su), bf_s(khi[3]) * (a1[3] * su));
                    ldsp vb2 = Vs + (16 * s2 + 8 * h + qsub) * VRS + (16 * blk + 4 * p4) * 2;
                    const bf16x8 B0 = cat8(lds_tr(vb2), lds_tr(vb2 + 4 * VRS));
                    const bf16x8 B1 = cat8(lds_tr(vb2 + 64), lds_tr(vb2 + 4 * VRS + 64));
                    c0 = MFMA32(Au, B0, c0); c1 = MFMA32(Au, B1, c1); nacc = MFMA32(Au, ONES, nacc);
                }
                {
                    ldsp Cw = lds + ML_C + (par ^ 1) * ML_CSZ;
#pragma unroll
                    for (int gq = 0; gq < 4; ++gq) {
                        const int d0 = 32 * w2 + 8 * gq + 4 * h;
                        u32x2 w; w.x = pk2(c0[4 * gq], c0[4 * gq + 1]); w.y = pk2(c0[4 * gq + 2], c0[4 * gq + 3]);
                        *(LAS u32x2*)(Cw + l31 * QRS + d0 * 2) = w;
                        w.x = pk2(c1[4 * gq], c1[4 * gq + 1]); w.y = pk2(c1[4 * gq + 2], c1[4 * gq + 3]);
                        *(LAS u32x2*)(Cw + (32 + l31) * QRS + d0 * 2) = w;
                        if (l31 == 0) { w.x = pk2(nacc[4 * gq], nacc[4 * gq + 1]); w.y = pk2(nacc[4 * gq + 2], nacc[4 * gq + 3]); *(LAS u32x2*)(Cw + 64 * QRS + d0 * 2) = w; }
                    }
                }
                mc = b_end + fmaxf(mc, pm_all);
            }
        }
#undef ML_LOAD
#undef ML_STORE
#undef ML_LD1
#undef ML_ST1
    }
    if (G >= 128 && first >= 64) {
        unsigned* cnt = (unsigned*)a.ws + 3520 + 64 * j;
        asm volatile("s_waitcnt vmcnt(0)" ::: "memory");
        __syncthreads();
        if (tid == 0) {
            __builtin_amdgcn_fence(__ATOMIC_RELEASE, "agent");
            asm volatile("s_waitcnt vmcnt(0)" ::: "memory");
            (void)__hip_atomic_fetch_add(cnt, 1u, __ATOMIC_RELAXED, __HIP_MEMORY_SCOPE_AGENT);
            unsigned sp = 0;
            while (__hip_atomic_load(cnt, __ATOMIC_RELAXED, __HIP_MEMORY_SCOPE_AGENT) < (unsigned)(G - 64)) { __builtin_amdgcn_s_sleep(2); if (++sp > (1u << 22)) break; }
            __builtin_amdgcn_fence(__ATOMIC_ACQUIRE, "agent");
            asm volatile("s_waitcnt vmcnt(0)" ::: "memory");
        }
        __syncthreads();
        hn_phase(a, j, NPROMPT, MTOK, first - 64, G - 64);
    }
}


__device__ __forceinline__ void hn_phase(const Args& a, int j, int row_lo, int row_hi, int bidx, int nblk) {
    const int tid_ = opaque_tid(); const int lane = tid_ & 63, wave = tid_ >> 6;
    const bf16_t* HF = (const bf16_t*)(a.ws + WS_R0);
    const bf16_t* HB = (const bf16_t*)(a.ws + WS_R0 + 4 * RSZ);
    const bf16_t* GG = (const bf16_t*)(a.ws + WS_R0 + 3 * RSZ);
    bf16_t* MO = (bf16_t*)(a.ws + WS_R0 + 2 * RSZ);
    const float* hn = a.in[8] + j * 1024 + 16 * lane;
    const f32x4 w0 = *(const f32x4*)(hn), w1 = *(const f32x4*)(hn + 4), w2 = *(const f32x4*)(hn + 8), w3 = *(const f32x4*)(hn + 12);
    for (int row = row_lo + bidx * 8 + wave; row < row_hi; row += nblk * 8) {
        const size_t off = (size_t)row * 1024 + 16 * lane;
        const u32x4 f0 = *(const u32x4*)(HF + off), f1 = *(const u32x4*)(HF + off + 8);
        const u32x4 b0 = *(const u32x4*)(HB + off), b1 = *(const u32x4*)(HB + off + 8);
        const u32x4 g0 = *(const u32x4*)(GG + off), g1 = *(const u32x4*)(GG + off + 8);
        float x0 = bf_lo(f0.x) + bf_lo(b0.x), x1 = bf_hi(f0.x) + bf_hi(b0.x), x2 = bf_lo(f0.y) + bf_lo(b0.y), x3 = bf_hi(f0.y) + bf_hi(b0.y);
        float x4 = bf_lo(f0.z) + bf_lo(b0.z), x5 = bf_hi(f0.z) + bf_hi(b0.z), x6 = bf_lo(f0.w) + bf_lo(b0.w), x7 = bf_hi(f0.w) + bf_hi(b0.w);
        float y0 = bf_lo(f1.x) + bf_lo(b1.x), y1 = bf_hi(f1.x) + bf_hi(b1.x), y2 = bf_lo(f1.y) + bf_lo(b1.y), y3 = bf_hi(f1.y) + bf_hi(b1.y);
        float y4 = bf_lo(f1.z) + bf_lo(b1.z), y5 = bf_hi(f1.z) + bf_hi(b1.z), y6 = bf_lo(f1.w) + bf_lo(b1.w), y7 = bf_hi(f1.w) + bf_hi(b1.w);
        float ss = x0 * x0 + x1 * x1 + x2 * x2 + x3 * x3 + x4 * x4 + x5 * x5 + x6 * x6 + x7 * x7 + y0 * y0 + y1 * y1 + y2 * y2 + y3 * y3 + y4 * y4 + y5 * y5 + y6 * y6 + y7 * y7;
        ss += __shfl_xor(ss, 1); ss += __shfl_xor(ss, 2); ss += __shfl_xor(ss, 4); ss += __shfl_xor(ss, 8);
        const float rs = rsqrtf(ss * (1.f / 256.f) + 1e-6f);
        u32x4 o0, o1;
        o0.x = pk2(x0 * rs * w0[0] * bf_lo(g0.x), x1 * rs * w0[1] * bf_hi(g0.x)); o0.y = pk2(x2 * rs * w0[2] * bf_lo(g0.y), x3 * rs * w0[3] * bf_hi(g0.y));
        o0.z = pk2(x4 * rs * w1[0] * bf_lo(g0.z), x5 * rs * w1[1] * bf_hi(g0.z)); o0.w = pk2(x6 * rs * w1[2] * bf_lo(g0.w), x7 * rs * w1[3] * bf_hi(g0.w));
        o1.x = pk2(y0 * rs * w2[0] * bf_lo(g1.x), y1 * rs * w2[1] * bf_hi(g1.x)); o1.y = pk2(y2 * rs * w2[2] * bf_lo(g1.y), y3 * rs * w2[3] * bf_hi(g1.y));
        o1.z = pk2(y4 * rs * w3[0] * bf_lo(g1.z), y5 * rs * w3[1] * bf_hi(g1.z)); o1.w = pk2(y6 * rs * w3[2] * bf_lo(g1.w), y7 * rs * w3[3] * bf_hi(g1.w));
        *(u32x4*)(MO + off) = o0; *(u32x4*)(MO + off + 8) = o1;
    }
}

#define XB_TMO      128
#define XB_XCNT(j)  (256  + 64 * (j))
#define XB_XSUB(j)  (1280 + 64 * (j))
#define XB_XGEN(j)  (2304 + 64 * (j))
#define XB_TOP      3328
#define XB_TOPGEN   3392
#define XCD_BAR_WORDS 3456
#define XB_SPIN_CAP (1u << 18)

__device__ __forceinline__ unsigned xb_ld(unsigned* p)              { return __hip_atomic_load(p, __ATOMIC_RELAXED, __HIP_MEMORY_SCOPE_AGENT); }
__device__ __forceinline__ unsigned xb_add(unsigned* p, unsigned v) { return __hip_atomic_fetch_add(p, v, __ATOMIC_RELAXED, __HIP_MEMORY_SCOPE_AGENT); }
__device__ __forceinline__ unsigned xb_xcc_id() { return (unsigned)__builtin_amdgcn_s_getreg((3 << 11) | 20) & 0xFu; }
#define XB_SPIN(cond, bar) do { unsigned _sp = 0; while (cond) { __builtin_amdgcn_s_sleep(1); \
    if ((++_sp & 255u) == 0u) { if (xb_ld(&(bar)[XB_TMO])) break; if (_sp > XB_SPIN_CAP) { atomicAdd(&(bar)[XB_TMO], 1u); break; } } } } while (0)

struct XcdBarrier {
    unsigned* bar; unsigned x;
    volatile LAS unsigned* st;
};

__device__ __forceinline__ XcdBarrier xcd_barrier_post(unsigned* bar, volatile LAS unsigned* st) {
    XcdBarrier b; b.bar = bar; b.x = xb_xcc_id(); b.st = st;
    if (threadIdx.x == 0) (void)xb_add(&bar[XB_XCNT(b.x)], 1u);
    return b;
}
__device__ __forceinline__ void xcd_barrier_complete(unsigned* bar, unsigned x, unsigned& nloc, unsigned& nx) {
    const unsigned G = gridDim.x * gridDim.y * gridDim.z;
    unsigned sum, cnt, mine, sp = 0u;
    for (;;) {
        sum = 0u; cnt = 0u; mine = 0u;
#pragma unroll
        for (unsigned j = 0; j < 16; ++j) { const unsigned c = xb_ld(&bar[XB_XCNT(j)]); sum += c; cnt += (c > 0u) ? 1u : 0u; mine = (j == x) ? c : mine; }
        if (sum == G) break;
        __builtin_amdgcn_s_sleep(1);
        if ((++sp & 255u) == 0u) { if (xb_ld(&bar[XB_TMO])) break; if (sp > XB_SPIN_CAP) { atomicAdd(&bar[XB_TMO], 1u); break; } }
    }
    nloc = mine > 0u ? mine : 1u; nx = cnt > 0u ? cnt : 1u;
}

__device__ __forceinline__ void xcd_barrier(const XcdBarrier& b) {
    asm volatile("s_waitcnt vmcnt(0)" ::: "memory");
    __syncthreads();
    if (threadIdx.x == 0) {
        unsigned* bar = b.bar;
        __builtin_amdgcn_s_waitcnt(0);
        unsigned nloc = b.st[0], nx = b.st[1];
        if (nloc == 0u) { xcd_barrier_complete(bar, b.x, nloc, nx); b.st[0] = nloc; b.st[1] = nx; }
        const unsigned old = xb_add(&bar[XB_XSUB(b.x)], 1u);
        const unsigned gen = old / nloc;
        if (old + 1u == (gen + 1u) * nloc) {
            __builtin_amdgcn_fence(__ATOMIC_RELEASE, "agent");
            asm volatile("s_waitcnt vmcnt(0)" ::: "memory");
            const unsigned og = xb_add(&bar[XB_TOP], 1u);
            const unsigned tg = og / nx;
            if (og + 1u == (tg + 1u) * nx) xb_add(&bar[XB_TOPGEN], 1u);
            else XB_SPIN(xb_ld(&bar[XB_TOPGEN]) == tg, bar);
            __builtin_amdgcn_fence(__ATOMIC_ACQUIRE, "agent");
            xb_add(&bar[XB_XGEN(b.x)], 1u);
            asm volatile("s_waitcnt vmcnt(0)" ::: "memory");
        } else {
            XB_SPIN(xb_ld(&bar[XB_XGEN(b.x)]) == gen, bar);
            __builtin_amdgcn_fence(__ATOMIC_ACQUIRE, "agent");
            asm volatile("s_waitcnt vmcnt(0)" ::: "memory");
        }
    }
    __syncthreads();
}

__global__ void __launch_bounds__(512, 2) fwd_kernel(Args a) {
    extern __shared__ __attribute__((aligned(16))) unsigned char lds_raw[];
    ldsp lds = (ldsp)lds_raw;
    cg::grid_group grid = cg::this_grid();
    const int G = gridDim.x;
    volatile LAS unsigned* bst = (volatile LAS unsigned*)(lds + LDS_BYTES - 64);
    if (threadIdx.x < 2) bst[threadIdx.x] = 0u;
    __syncthreads();
    const XcdBarrier xbar = xcd_barrier_post((unsigned*)a.ws, bst);
    for (int ph = a.ph_lo; ph < a.ph_hi; ++ph) {
        if (ph == 0) { prep_phase(a, lds, G); norm_phase(a, 0, G); }
        else if (ph == NPHASE - 1) { norm_phase(a, 2, G); }
        else {
            const int p = ph - 1, j = p >> 3, r = p & 7;
            bf16_t* R0 = (bf16_t*)(a.ws + WS_R0);
            bf16_t* R1 = (bf16_t*)(a.ws + WS_R0 + 1 * RSZ);
            bf16_t* R2 = (bf16_t*)(a.ws + WS_R0 + 2 * RSZ);
            bf16_t* R3 = (bf16_t*)(a.ws + WS_R0 + 3 * RSZ);
            bf16_t* R4 = (bf16_t*)(a.ws + WS_R0 + 4 * RSZ);
            u64_t* SS = (u64_t*)(a.ws + WS_SS);
            if (r == 0) { for (int rep = 0; rep < DUP(1); ++rep) {
                pg8::Gemm g{R0, (const bf16_t*)(a.ws + WS_WA + j * WA_SZ), MTOK, 2560, 1024};
                pg8::StaticOrder S; S.init(MTOK, 2560, G, opaque_bid());
                pg8::EpiAttnIn E{R1, R2, R2 + (size_t)MTOK * 256, R3, (const float*)(a.ws + WS_ROPE), SS + (size_t)(2 * j) * MTOK};
                pg8::gemm_phase<pg8::EpiAttnIn, pg8::StaticOrder, true, true>(lds, g, S, E); }
            } else if (r == 1) { for (int rep = 0; rep < DUP(2); ++rep) attn_phase(a, lds, j, G); }
            else if (r == 2 || r == 7) {
                const int lnext = 2 * j + (r == 2 ? 1 : 2);
                pg8::Gemm g{r == 2 ? R4 : R2, (const bf16_t*)(a.ws + (r == 2 ? WS_WAO : WS_WMO) + j * WO_SZ), MTOK, 1024, 1024};
                pg8::StaticOrder S; S.init(MTOK, 1024, G, opaque_bid());
                pg8::EpiResid E{ph == 3 ? a.in[0] : nullptr, ph == 3 ? a.in[1] : nullptr, a.out, R0, lnext < 4 ? SS + (size_t)lnext * MTOK : nullptr};
                pg8::gemm_phase<pg8::EpiResid, pg8::StaticOrder, true, true>(lds, g, S, E);
            } else if (r == 3) { for (int rep = 0; rep < DUP(5); ++rep) {
                pg8::Gemm g{R0, (const bf16_t*)(a.ws + WS_WM + j * WM_SZ), MTOK, 4352, 1024};
                pg8::StaticOrder S; S.init(MTOK, 4352, G, opaque_bid());
                pg8::EpiMlstmIn E{R1, R1 + (size_t)MTOK * 512, R2, R3, (float*)(a.ws + WS_GATES), a.in[7] + j * 16, SS + (size_t)(2 * j + 1) * MTOK};
                pg8::gemm_phase<pg8::EpiMlstmIn, pg8::StaticOrder, true, true>(lds, g, S, E); }
            } else if (r == 4) { gatescan_phase(a, G); }
            else if (r == 5) { mlstm_phase(a, lds, j, G); }
            else { if (G >= 128) hn_phase(a, j, 0, NPROMPT, opaque_bid(), G); else hn_phase(a, j, 0, MTOK, opaque_bid(), G); }
        }
        if (ph + 1 < a.ph_hi) {
            if (a.ph_hi > NPHASE) grid.sync();
            else xcd_barrier(xbar);
#ifdef DUP_SYNC
            xcd_barrier(xbar); xcd_barrier(xbar);
#endif
        }
    }
}

extern "C" void kernel_launch(void* const* d_in, const int* in_sizes, int n_in, void* d_out, int out_size, void* d_ws, size_t ws_size, hipStream_t stream) {
    static int grid = 0;
    if (grid == 0) {
        if (n_in != 11 || out_size != MTOK * DM || ws_size < WS_END) { fprintf(stderr, "kernel_launch: unexpected problem (n_in %d, out %d, ws %zu; need ws >= %zu)\n", n_in, out_size, ws_size, (size_t)WS_END); grid = -1; return; }
        int dev = 0, cus = 0, per_cu = 0;
        if (hipGetDevice(&dev) != hipSuccess || hipDeviceGetAttribute(&cus, hipDeviceAttributeMultiprocessorCount, dev) != hipSuccess) { grid = -1; return; }
        if (hipFuncSetAttribute((const void*)fwd_kernel, hipFuncAttributeMaxDynamicSharedMemorySize, LDS_BYTES) != hipSuccess) { fprintf(stderr, "kernel_launch: hipFuncSetAttribute failed\n"); grid = -1; return; }
        if (hipOccupancyMaxActiveBlocksPerMultiprocessor(&per_cu, (const void*)fwd_kernel, 512, LDS_BYTES) != hipSuccess || per_cu < 1) { fprintf(stderr, "kernel_launch: occupancy query says %d\n", per_cu); (void)hipGetLastError(); per_cu = 1; }
        grid = cus * per_cu;
    }
    if (grid < 0) return;
    if (hipMemsetAsync(d_ws, 0, 16384, stream) != hipSuccess) { fprintf(stderr, "kernel_launch: memset failed\n"); return; }
    Args a{};
    for (int i = 0; i < 11; ++i) a.in[i] = (const float*)d_in[i];
    a.out = (float*)d_out; a.ws = (unsigned char*)d_ws;
#if MK_MULTI
    for (int ph = 0; ph < NPHASE; ++ph) { a.ph_lo = ph; a.ph_hi = ph + 1; hipLaunchKernelGGL(fwd_kernel, dim3(grid), dim3(512), LDS_BYTES, stream, a); }
#else
    a.ph_lo = 0; a.ph_hi = NPHASE;
    void* args[] = {&a};
    hipError_t e = hipLaunchCooperativeKernel((void*)fwd_kernel, dim3(grid), dim3(512), args, LDS_BYTES, stream);
    if (e != hipSuccess) fprintf(stderr, "kernel_launch: cooperative launch failed: %s (grid %d)\n", hipGetErrorString(e), grid);
#endif
}
```
